# Optimizing an MI355X kernel written in HIP

```python
import math
import jax, jax.numpy as jnp
from jax import lax
import numpy as np

D_MODEL = 2048
BATCH = 1
SEQ = 8192
DEPTH = 1

CHUNK = 64
Q_BLOCK = 128
EPS = 1e-6
SB_HEADS = 8
SB_HEAD_DIM = 128
SB_WIDTH = SB_HEADS * SB_HEAD_DIM
MLA_HEADS = 8
MLA_NOPE_DIM = 128
MLA_ROPE_DIM = 64
MLA_QK_DIM = MLA_NOPE_DIM + MLA_ROPE_DIM
MLA_V_DIM = 128
MLA_WIDTH = MLA_HEADS * MLA_V_DIM
Q_LORA_RANK = 512
KV_LORA_RANK = 256
ROPE_THETA = 10000.0
D_MIX = SB_WIDTH + MLA_WIDTH
IN_SPLITS = (SB_WIDTH, SB_WIDTH, SB_WIDTH, SB_WIDTH,
             Q_LORA_RANK, KV_LORA_RANK, MLA_ROPE_DIM, MLA_WIDTH)
D_IN = sum(IN_SPLITS)

kernel_name = 'hybrid_stickbreak_mla_block'


def rms_norm(x, w):
    xf = x.astype(jnp.float32)
    y = xf * lax.rsqrt(jnp.mean(xf * xf, axis=-1, keepdims=True) + EPS)
    return (y * w.astype(jnp.float32)).astype(x.dtype)


def rope_tables(positions):
    inv_freq = ROPE_THETA ** (-jnp.arange(0, MLA_ROPE_DIM, 2, dtype=jnp.float32) / MLA_ROPE_DIM)
    ang = positions.astype(jnp.float32)[..., None] * inv_freq
    return jnp.cos(ang), jnp.sin(ang)


def apply_rope(x, cos, sin):
    x1, x2 = jnp.split(x.astype(jnp.float32), 2, axis=-1)
    out = jnp.concatenate([x1 * cos - x2 * sin, x2 * cos + x1 * sin], axis=-1)
    return out.astype(x.dtype)


def to_heads(t, n_heads):
    b, s, _ = t.shape
    return t.reshape(b, s, n_heads, -1).transpose(0, 2, 1, 3)


def from_heads(t):
    b, h, s, d = t.shape
    return t.transpose(0, 2, 1, 3).reshape(b, s, h * d)


def stick_breaking_attention(q, k, v):
    seq, d = q.shape[2], q.shape[3]
    scale = 1.0 / math.sqrt(d)
    outs = []
    for b0 in range(0, seq, Q_BLOCK):
        kl = b0 + Q_BLOCK
        z = jnp.einsum('bhqd,bhkd->bhqk', q[:, :, b0:kl], k[:, :, :kl]).astype(jnp.float32) * scale
        t_idx = b0 + jnp.arange(Q_BLOCK)[:, None]
        s_idx = jnp.arange(kl)[None, :]
        before = s_idx < t_idx
        log_keep = jnp.where(before, jax.nn.log_sigmoid(-z), 0.0)
        later = lax.cumsum(log_keep, axis=3, reverse=True) - log_keep
        a = jnp.where(before, jnp.exp(jax.nn.log_sigmoid(z) + later), 0.0)
        outs.append(jnp.einsum('bhqk,bhkd->bhqd', a.astype(v.dtype), v[:, :, :kl]))
    return jnp.concatenate(outs, axis=2)


def chunk_causal_softmax_attention(q, k, v):
    seq, d = q.shape[2], q.shape[3]
    scale = 1.0 / math.sqrt(d)
    outs = []
    for b0 in range(0, seq, Q_BLOCK):
        kl = b0 + Q_BLOCK
        s_ = jnp.einsum('bhqd,bhkd->bhqk', q[:, :, b0:kl], k[:, :, :kl]).astype(jnp.float32) * scale
        t_chunk = (b0 + jnp.arange(Q_BLOCK))[:, None] // CHUNK
        s_chunk = jnp.arange(kl)[None, :] // CHUNK
        s_ = jnp.where(s_chunk <= t_chunk, s_, -jnp.inf)
        p = jax.nn.softmax(s_, axis=-1)
        outs.append(jnp.einsum('bhqk,bhkd->bhqd', p.astype(v.dtype), v[:, :, :kl]))
    return jnp.concatenate(outs, axis=2)


def hybrid_layer(x, cos, sin, pre_norm_w, w_in, q_norm_w, w_q_up, kv_norm_w, w_kv_up, w_out, post_norm_w):
    b, s, _ = x.shape
    h = rms_norm(x, pre_norm_w)
    proj = h @ w_in
    split_pts = tuple(int(i) for i in np.cumsum(IN_SPLITS)[:-1])
    sb_q, sb_k, sb_v, sb_gate, c_q, c_kv, k_rope, mla_gate = jnp.split(proj, split_pts, axis=-1)

    o_a = from_heads(stick_breaking_attention(to_heads(sb_q, SB_HEADS),
                                              to_heads(sb_k, SB_HEADS),
                                              to_heads(sb_v, SB_HEADS)))

    q_full = (rms_norm(c_q, q_norm_w) @ w_q_up).reshape(b, s, MLA_HEADS, MLA_QK_DIM)
    q_nope, q_rot = jnp.split(q_full, [MLA_NOPE_DIM], axis=-1)
    q_rot = apply_rope(q_rot, cos[:, :, None, :], sin[:, :, None, :])
    kv = (rms_norm(c_kv, kv_norm_w) @ w_kv_up).reshape(b, s, MLA_HEADS, MLA_NOPE_DIM + MLA_V_DIM)
    k_nope, v_mla = jnp.split(kv, [MLA_NOPE_DIM], axis=-1)
    k_rot = apply_rope(k_rope, cos, sin)
    k_rot = jnp.broadcast_to(k_rot[:, :, None, :], (b, s, MLA_HEADS, MLA_ROPE_DIM))
    q_mla = jnp.concatenate([q_nope, q_rot], axis=-1).transpose(0, 2, 1, 3)
    k_mla = jnp.concatenate([k_nope, k_rot], axis=-1).transpose(0, 2, 1, 3)
    o_b = from_heads(chunk_causal_softmax_attention(q_mla, k_mla, v_mla.transpose(0, 2, 1, 3)))

    mixed = jnp.concatenate([o_a * jax.nn.silu(sb_gate), o_b * jax.nn.silu(mla_gate)], axis=-1)
    y = mixed @ w_out
    return x + rms_norm(y, post_norm_w)


def setup_inputs(seed: int = 0) -> dict:
    key = jax.random.key(seed)
    ks = jax.random.split(key, 12)
    f32 = jnp.float32
    x = jax.random.normal(ks[0], (BATCH, SEQ, D_MODEL), f32)
    positions = jnp.broadcast_to(jnp.arange(SEQ, dtype=jnp.int32)[None, :], (BATCH, SEQ))
    pre_norm_w = 1.0 + 0.05 * jax.random.normal(ks[1], (DEPTH, D_MODEL), f32)
    w_in = jax.random.normal(ks[2], (DEPTH, D_MODEL, D_IN), f32) * D_MODEL ** -0.5
    q_norm_w = 1.0 + 0.05 * jax.random.normal(ks[3], (DEPTH, Q_LORA_RANK), f32)
    w_q_up = jax.random.normal(ks[4], (DEPTH, Q_LORA_RANK, MLA_HEADS * MLA_QK_DIM), f32) * Q_LORA_RANK ** -0.5
    kv_norm_w = 1.0 + 0.05 * jax.random.normal(ks[5], (DEPTH, KV_LORA_RANK), f32)
    w_kv_up = jax.random.normal(ks[6], (DEPTH, KV_LORA_RANK, MLA_HEADS * (MLA_NOPE_DIM + MLA_V_DIM)), f32) * KV_LORA_RANK ** -0.5
    w_out = jax.random.normal(ks[7], (DEPTH, D_MIX, D_MODEL), f32) * D_MIX ** -0.5
    post_norm_w = 1.0 + 0.05 * jax.random.normal(ks[8], (DEPTH, D_MODEL), f32)
    return {'x': x, 'positions': positions, 'pre_norm_w': pre_norm_w, 'w_in': w_in,
            'q_norm_w': q_norm_w, 'w_q_up': w_q_up, 'kv_norm_w': kv_norm_w, 'w_kv_up': w_kv_up,
            'w_out': w_out, 'post_norm_w': post_norm_w}


def reference(x, positions, pre_norm_w, w_in, q_norm_w, w_q_up, kv_norm_w, w_kv_up, w_out, post_norm_w):
    cos, sin = rope_tables(positions)
    for i in range(DEPTH):
        x = hybrid_layer(x, cos, sin, pre_norm_w[i], w_in[i], q_norm_w[i], w_q_up[i],
                         kv_norm_w[i], w_kv_up[i], w_out[i], post_norm_w[i])
    return x
```

```cpp
#include <hip/hip_runtime.h>
#include <hip/hip_cooperative_groups.h>
#include <cstdio>
namespace cg = cooperative_groups;

#define DI __device__ __forceinline__
typedef unsigned short u16;
using bf16x8 = __attribute__((ext_vector_type(8))) short;
using f32x16 = __attribute__((ext_vector_type(16))) float;
using f32x4  = __attribute__((ext_vector_type(4))) float;
using f32x2  = __attribute__((ext_vector_type(2))) float;
using u32x4  = __attribute__((ext_vector_type(4))) unsigned;
using u32x2  = __attribute__((ext_vector_type(2))) unsigned;
typedef __bf16 bf16x2_t __attribute__((ext_vector_type(2)));

constexpr int S = 8192, DM = 2048, DIN = 5952, DINP = 6016;
constexpr float EPS = 1e-6f;

constexpr size_t OFF_XB    = 0;
constexpr size_t OFF_WINT  = OFF_XB   + (size_t)S * DM * 2;
constexpr size_t OFF_WQT   = OFF_WINT + (size_t)DINP * DM * 2;
constexpr size_t OFF_WKVT  = OFF_WQT  + (size_t)1536 * 512 * 2;
constexpr size_t OFF_WOT   = OFF_WKVT + (size_t)2048 * 256 * 2;
constexpr size_t OFF_RSTDX = OFF_WOT  + (size_t)2048 * 2048 * 2;
constexpr size_t OFF_COS   = OFF_RSTDX + (size_t)S * 4;
constexpr size_t OFF_SIN   = OFF_COS  + (size_t)S * 32 * 4;
constexpr size_t OFF_SBQ   = OFF_SIN  + (size_t)S * 32 * 4;
constexpr size_t OFF_SBK   = OFF_SBQ  + (size_t)S * 1024 * 2;
constexpr size_t OFF_SBVT  = OFF_SBK  + (size_t)S * 1024 * 2;
constexpr size_t OFF_GATE  = OFF_SBVT + (size_t)S * 1024 * 2;
constexpr size_t OFF_CQ    = OFF_GATE + (size_t)S * 2048 * 2;
constexpr size_t OFF_CKV   = OFF_CQ   + (size_t)S * 512 * 2;
constexpr size_t OFF_KROT  = OFF_CKV  + (size_t)S * 256 * 2;
constexpr size_t OFF_CQSS  = OFF_KROT + (size_t)S * 64 * 2;
constexpr size_t OFF_CKVSS = OFF_CQSS + (size_t)S * 8 * 4;
constexpr size_t OFF_QMLA  = OFF_CKVSS + (size_t)S * 4 * 4;
constexpr size_t OFF_KNOPE = OFF_QMLA + (size_t)S * 1536 * 2;
constexpr size_t OFF_MVT   = OFF_KNOPE + (size_t)S * 1024 * 2;
constexpr size_t OFF_YSS   = OFF_MVT  + (size_t)S * 1024 * 2;
constexpr size_t OFF_CTR   = OFF_YSS  + (size_t)S * 32 * 4;
constexpr size_t OFF_BAR   = OFF_CTR + 2048;
constexpr size_t WS_END    = OFF_BAR + 16384;
constexpr size_t OFF_MIXED = OFF_XB;
constexpr size_t OFF_PART  = OFF_WINT;
constexpr size_t PART_STRIDE = 65536 + 2048;
static_assert(256 * PART_STRIDE <= (size_t)DINP * DM * 2, "partials must fit in the dead w_in^T region");
constexpr size_t OFF_FLAG  = OFF_CTR + 64;
constexpr size_t OFF_Y     = OFF_SBQ;

constexpr int LDS_BYTES = 73728 + 256;
constexpr int LDS_BARST = 73728;

struct Params {
  const float* x; const int* pos; const float* pre_w; const float* w_in; const float* qn_w; const float* w_qup;
  const float* kvn_w; const float* w_kvup; const float* w_out; const float* post_w; float* out; unsigned char* ws;
};

DI unsigned pack2(float lo, float hi) { f32x2 v = {lo, hi}; bf16x2_t r = __builtin_convertvector(v, bf16x2_t); return __builtin_bit_cast(unsigned, r); }
DI float bflo(unsigned w) { return __uint_as_float(w << 16); }
DI float bfhi(unsigned w) { return __uint_as_float(w & 0xffff0000u); }
DI void store4bf(u16* dst, float a, float b, float c, float d) { u32x2 v = {pack2(a, b), pack2(c, d)}; *(u32x2*)dst = v; }
DI float xhalf_sum(float v) { auto rr = __builtin_amdgcn_permlane32_swap(__float_as_uint(v), __float_as_uint(v), false, false); return __uint_as_float(rr[0]) + __uint_as_float(rr[1]); }
DI float xhalf_max(float v) { auto rr = __builtin_amdgcn_permlane32_swap(__float_as_uint(v), __float_as_uint(v), false, false); return fmaxf(__uint_as_float(rr[0]), __uint_as_float(rr[1])); }
DI float xhalf_other(float v, int h) { auto rr = __builtin_amdgcn_permlane32_swap(__float_as_uint(v), __float_as_uint(v), false, false); return __uint_as_float(h ? rr[0] : rr[1]); }
DI float wave_sum(float v, int lane) {
#pragma unroll
  for (int o = 32; o > 0; o >>= 1) v += __int_as_float(__builtin_amdgcn_ds_bpermute((lane ^ o) << 2, __float_as_int(v)));
  return v;
}
DI int fresh_tid() { int t = threadIdx.x; asm volatile("" : "+v"(t)); return t; }
DI float silu(float v) { return v * __builtin_amdgcn_rcpf(1.f + __builtin_amdgcn_exp2f(-1.4426950408889634f * v)); }
DI void dma16(const void* gsrc, char* lds_wave_base) { __builtin_amdgcn_global_load_lds((const unsigned*)gsrc, (unsigned*)lds_wave_base, 16, 0, 0); }

template <int OFF> DI void ds_rd128(bf16x8& dst, unsigned addr) { asm volatile("ds_read_b128 %0, %1 offset:%2" : "=v"(dst) : "v"(addr), "i"(OFF)); }
template <int OFF> DI void ds_rd64(u32x2& dst, unsigned addr)  { asm volatile("ds_read_b64 %0, %1 offset:%2" : "=v"(dst) : "v"(addr), "i"(OFF)); }
template <int N> DI void lgkm_wait1(bf16x8& a) { asm volatile("s_waitcnt lgkmcnt(%1)" : "+v"(a) : "i"(N)); }
template <int N> DI void lgkm_wait2(bf16x8& a, bf16x8& b) { asm volatile("s_waitcnt lgkmcnt(%2)" : "+v"(a), "+v"(b) : "i"(N)); }
template <int N> DI void lgkm_wait2(u32x2& a, u32x2& b)   { asm volatile("s_waitcnt lgkmcnt(%2)" : "+v"(a), "+v"(b) : "i"(N)); }

DI u32x4 widen16(u32x2 a, u32x2 b) {
  auto r0 = __builtin_amdgcn_permlane32_swap(a[0], b[0], false, false);
  auto r1 = __builtin_amdgcn_permlane32_swap(a[1], b[1], false, false);
  u32x4 w = {r0[0], r1[0], r0[1], r1[1]};
  return w;
}

DI float vmax3(float a, float b, float c) { float r; asm("v_max3_f32 %0, %1, %2, %3" : "=v"(r) : "v"(a), "v"(b), "v"(c)); return r; }
DI float vmax3_first(float a, float b, float c) { float r; asm("s_nop 11\n\tv_max3_f32 %0, %1, %2, %3" : "=v"(r) : "v"(a), "v"(b), "v"(c)); return r; }
#define MFMA(a, b, c) __builtin_amdgcn_mfma_f32_32x32x16_bf16((a), (b), (c), 0, 0, 0)

constexpr int GM = 256, GN = 128, G_STAGE_B = 24576;
DI size_t kblk(int rows, int row, int k) { return ((size_t)(k >> 5) * rows + row) * 32 + (k & 31); }
template <bool SWAP>
DI void gemm_mainloop(f32x16 (&acc)[4][2], const u16* __restrict__ A, int lda, const u16* __restrict__ Bt, int ldb, int K, int m0, int n0, char* lds) {
  const int tid = fresh_tid(), wid = __builtin_amdgcn_readfirstlane(tid >> 6), lane = tid & 63, r32 = lane & 31, h = lane >> 5, wr = wid >> 1, wc = wid & 1;
#pragma unroll
  for (int a = 0; a < 4; ++a)
#pragma unroll
    for (int b = 0; b < 2; ++b)
#pragma unroll
      for (int r = 0; r < 16; ++r) acc[a][b][r] = 0.f;
  const int srow = wid * 16 + (lane >> 2);
  const int schunk = (lane & 3) ^ ((lane >> 4) & 3);
  const char* Ab = (const char*)(A + (size_t)m0 * 32);
  const char* Bb = (const char*)(Bt + (size_t)n0 * 32);
  const unsigned aoff = (unsigned)((srow * 32 + schunk * 8) * 2), boff = aoff;
  const size_t astage = (size_t)lda * 64, bstage = (size_t)ldb * 64;
  char* wbase = lds + wid * 1024 + lane * 16;
  u32x4 ra[4], rb[2];
#define G_LOAD(s_) do { const char* a_ = Ab + (size_t)(s_) * astage + aoff; const char* b_ = Bb + (size_t)(s_) * bstage + boff; \
    _Pragma("unroll") for (int i = 0; i < 4; ++i) ra[i] = *(const u32x4*)(a_ + i * 4096); \
    _Pragma("unroll") for (int i = 0; i < 2; ++i) rb[i] = *(const u32x4*)(b_ + i * 4096); } while (0)
#define G_WRITE(bufoff) do { \
    _Pragma("unroll") for (int i = 0; i < 4; ++i) *(u32x4*)(wbase + (bufoff) + i * 4096) = ra[i]; \
    _Pragma("unroll") for (int i = 0; i < 2; ++i) *(u32x4*)(wbase + (bufoff) + 16384 + i * 4096) = rb[i]; } while (0)
  const int nk = K >> 5;
  __syncthreads();
  G_LOAD(0); G_WRITE(0); G_LOAD(1);
  __syncthreads();
  const int swz = (r32 >> 2) & 3;
  const int arow = (wr * 128 + r32) * 64, brow = 16384 + (wc * 64 + r32) * 64;
  bf16x8 af[2][4], bfr[2][2];
#define F_READ(set, St_) do { const int co_ = ((2 * (set) + h) ^ swz) << 4; \
    _Pragma("unroll") for (int t = 0; t < 4; ++t) af[set][t] = *(const bf16x8*)((St_) + arow + t * 2048 + co_); \
    _Pragma("unroll") for (int t = 0; t < 2; ++t) bfr[set][t] = *(const bf16x8*)((St_) + brow + t * 2048 + co_); } while (0)
#define F_MMA(set) do { _Pragma("unroll") for (int mt = 0; mt < 4; ++mt) _Pragma("unroll") for (int nt = 0; nt < 2; ++nt) \
    acc[mt][nt] = SWAP ? MFMA(af[set][mt], bfr[set][nt], acc[mt][nt]) : MFMA(bfr[set][nt], af[set][mt], acc[mt][nt]); } while (0)
#pragma unroll 1
  for (int s_ = 0; s_ < nk; ++s_) {
    const int cur = (s_ & 1) * G_STAGE_B, nxt = G_STAGE_B - cur;
    const char* St = lds + cur;
    F_READ(0, St);
    __builtin_amdgcn_sched_barrier(0);
    if (s_ > 0) F_MMA(1);
    __builtin_amdgcn_sched_barrier(0);
    F_READ(1, St);
    if (s_ + 1 < nk) G_WRITE(nxt);
    if (s_ + 2 < nk) G_LOAD(s_ + 2);
    __builtin_amdgcn_sched_barrier(0);
    F_MMA(0);
    __builtin_amdgcn_sched_barrier(0);
    __syncthreads();
  }
  F_MMA(1);
#undef F_READ
#undef F_MMA
#undef G_LOAD
#undef G_WRITE
}

template <bool SILU, bool KB = false>
DI void store_strip(const f32x16 (&acc)[4][2], u16* base, int ld, int col0, int tok0, const float (&rs)[4], int r32, int h) {
#pragma unroll
  for (int mt = 0; mt < 4; ++mt) {
    u16* rowp = KB ? base + kblk(S, tok0 + mt * 32 + r32, col0) + 8 * h : base + (size_t)(tok0 + mt * 32 + r32) * ld + col0 + 8 * h;
    const size_t ntstep = KB ? (size_t)S * 32 : 32;
#pragma unroll
    for (int nt = 0; nt < 2; ++nt)
#pragma unroll
      for (int k = 0; k < 2; ++k) {
        u32x2 pk[2];
#pragma unroll
        for (int e = 0; e < 2; ++e) {
          const int g = 2 * k + e;
          float v0 = acc[mt][nt][4 * g] * rs[mt], v1 = acc[mt][nt][4 * g + 1] * rs[mt], v2 = acc[mt][nt][4 * g + 2] * rs[mt], v3 = acc[mt][nt][4 * g + 3] * rs[mt];
          if (SILU) { v0 = silu(v0); v1 = silu(v1); v2 = silu(v2); v3 = silu(v3); }
          pk[e][0] = pack2(v0, v1); pk[e][1] = pack2(v2, v3);
        }
        *(u32x4*)(rowp + nt * ntstep + 16 * k) = widen16(pk[0], pk[1]);
      }
    __builtin_amdgcn_sched_barrier(0);
  }
}
template <bool SILU>
DI void store_strip_rows(const f32x16 (&acc)[4][2], u16* base, int ld, int col0, int tok0, const float (&rs)[4], int r32, int h, char* lds, int wid, int lane) {
  char* wl = lds + wid * 16384;
#pragma unroll
  for (int mt = 0; mt < 4; ++mt) {
    const int row = mt * 32 + r32;
#pragma unroll
    for (int nt = 0; nt < 2; ++nt)
#pragma unroll
      for (int k = 0; k < 2; ++k) {
        u32x2 pk[2];
#pragma unroll
        for (int e = 0; e < 2; ++e) {
          const int g = 2 * k + e;
          float v0 = acc[mt][nt][4 * g] * rs[mt], v1 = acc[mt][nt][4 * g + 1] * rs[mt], v2 = acc[mt][nt][4 * g + 2] * rs[mt], v3 = acc[mt][nt][4 * g + 3] * rs[mt];
          if (SILU) { v0 = silu(v0); v1 = silu(v1); v2 = silu(v2); v3 = silu(v3); }
          pk[e][0] = pack2(v0, v1); pk[e][1] = pack2(v2, v3);
        }
        const int c = nt * 4 + 2 * k + h;
        *(u32x4*)(wl + row * 128 + ((c ^ (row & 7)) << 4)) = widen16(pk[0], pk[1]);
      }
    __builtin_amdgcn_sched_barrier(0);
  }
  const int rr = lane >> 3, c = lane & 7;
  u16* gp = base + (size_t)(tok0 + rr) * ld + col0 + c * 8;
#pragma unroll
  for (int i = 0; i < 16; ++i) {
    const int row = i * 8 + rr;
    const u32x4 v = *(const u32x4*)(wl + row * 128 + ((c ^ (row & 7)) << 4));
    *(u32x4*)(gp + (size_t)(i * 8) * ld) = v;
  }
}
DI void store_rope_strip(const f32x16 (&acc)[4][2], u16* base, int ld, int col0, int tok0, const float (&rs)[4], int r32, int h, const float* COS, const float* SIN) {
#pragma unroll
  for (int mt = 0; mt < 4; ++mt) {
    const int tok = tok0 + mt * 32 + r32;
    u16* rowp = base + (size_t)tok * ld + col0 + 4 * h;
#pragma unroll
    for (int g = 0; g < 4; ++g) {
      const f32x4 c = *(const f32x4*)(COS + (size_t)tok * 32 + 8 * g + 4 * h);
      const f32x4 s = *(const f32x4*)(SIN + (size_t)tok * 32 + 8 * g + 4 * h);
      float o1[4], o2[4];
#pragma unroll
      for (int i = 0; i < 4; ++i) {
        const float x1 = acc[mt][0][4 * g + i] * rs[mt], x2 = acc[mt][1][4 * g + i] * rs[mt];
        o1[i] = x1 * c[i] - x2 * s[i]; o2[i] = x2 * c[i] + x1 * s[i];
      }
      store4bf(rowp + 8 * g, o1[0], o1[1], o1[2], o1[3]);
      store4bf(rowp + 32 + 8 * g, o2[0], o2[1], o2[2], o2[3]);
      __builtin_amdgcn_sched_barrier(0);
    }
  }
}
DI void strip_sumsq(const f32x16 (&acc)[4][2], float* ss, int nslot, int slot, int tok0, const float (&rs)[4], int r32, int h) {
#pragma unroll
  for (int mt = 0; mt < 4; ++mt) {
    float s = 0.f;
#pragma unroll
    for (int nt = 0; nt < 2; ++nt)
#pragma unroll
      for (int r = 0; r < 16; ++r) { const float v = acc[mt][nt][r] * rs[mt]; s += v * v; }
    s = xhalf_sum(s);
    if (h == 0) ss[(size_t)(tok0 + mt * 32 + r32) * nslot + slot] = s;
  }
}
template <bool KVSS>
DI void store_strip_T(const f32x16 (&acc)[4][2], u16* baseT, int feat0, int tok0, const float* rsrc, int r32, int h) {
#pragma unroll
  for (int mt = 0; mt < 4; ++mt)
#pragma unroll
    for (int k = 0; k < 2; ++k) {
      f32x4 r4[2];
#pragma unroll
      for (int e = 0; e < 2; ++e) {
        const int tb = tok0 + mt * 32 + 8 * (2 * k + e) + 4 * h;
        if (KVSS) {
#pragma unroll
          for (int i = 0; i < 4; ++i) { const f32x4 a = *(const f32x4*)(rsrc + (size_t)(tb + i) * 4); r4[e][i] = rsqrtf(((a[0] + a[1]) + (a[2] + a[3])) * (1.f / 256.f) + EPS); }
        } else r4[e] = *(const f32x4*)(rsrc + tb);
      }
#pragma unroll
      for (int nt = 0; nt < 2; ++nt) {
        u32x2 pk[2];
#pragma unroll
        for (int e = 0; e < 2; ++e) {
          const int g = 2 * k + e;
          pk[e][0] = pack2(acc[mt][nt][4 * g] * r4[e][0], acc[mt][nt][4 * g + 1] * r4[e][1]);
          pk[e][1] = pack2(acc[mt][nt][4 * g + 2] * r4[e][2], acc[mt][nt][4 * g + 3] * r4[e][3]);
        }
        const u32x4 w_ = {pk[0][0], pk[0][1], pk[1][0], pk[1][1]};
        *(u32x4*)(baseT + (size_t)(feat0 + nt * 32 + r32) * S + tok0 + mt * 32 + 16 * k + 8 * h) = w_;
      }
    }
}

DI void p1_tile(const Params& p, int tm, int tn, char* lds) {
  unsigned char* ws = p.ws;
  const int wid = __builtin_amdgcn_readfirstlane(fresh_tid() >> 6), wr = wid >> 1, wc = wid & 1;
  const int m0 = tm * GM, n0 = tn * GN;
  const u16* A = (const u16*)(ws + OFF_XB); const u16* Bt = (const u16*)(ws + OFF_WINT);
  const float* rstdx = (const float*)(ws + OFF_RSTDX);
  const int tok0 = m0 + wr * 128;
  f32x16 acc[4][2];
  if (n0 >= 2048 && n0 < 3072) {
    gemm_mainloop<true>(acc, A, S, Bt, DINP, DM, m0, n0, lds);
    const int lane = fresh_tid() & 63, r32 = lane & 31, h = lane >> 5;
    store_strip_T<false>(acc, (u16*)(ws + OFF_SBVT), n0 - 2048 + wc * 64, tok0, rstdx, r32, h);
    return;
  }
  gemm_mainloop<false>(acc, A, S, Bt, DINP, DM, m0, n0, lds);
  const int lane = fresh_tid() & 63, r32 = lane & 31, h = lane >> 5;
  float rs[4];
#pragma unroll
  for (int mt = 0; mt < 4; ++mt) rs[mt] = rstdx[tok0 + mt * 32 + r32];
  const int fb = n0 + wc * 64;
  if (fb < 1024)      store_strip_rows<false>(acc, (u16*)(ws + OFF_SBQ), 1024, fb, tok0, rs, r32, h, lds, wid, lane);
  else if (fb < 2048) store_strip_rows<false>(acc, (u16*)(ws + OFF_SBK), 1024, fb - 1024, tok0, rs, r32, h, lds, wid, lane);
  else if (fb < 4096) store_strip_rows<true>(acc, (u16*)(ws + OFF_GATE), 2048, fb - 3072, tok0, rs, r32, h, lds, wid, lane);
  else if (fb < 4608) { store_strip<false, true>(acc, (u16*)(ws + OFF_CQ), 512, fb - 4096, tok0, rs, r32, h); strip_sumsq(acc, (float*)(ws + OFF_CQSS), 8, (fb - 4096) >> 6, tok0, rs, r32, h); }
  else if (fb < 4864) { store_strip<false, true>(acc, (u16*)(ws + OFF_CKV), 256, fb - 4608, tok0, rs, r32, h); strip_sumsq(acc, (float*)(ws + OFF_CKVSS), 4, (fb - 4608) >> 6, tok0, rs, r32, h); }
  else if (fb < 4928) store_rope_strip(acc, (u16*)(ws + OFF_KROT), 64, 0, tok0, rs, r32, h, (const float*)(ws + OFF_COS), (const float*)(ws + OFF_SIN));
  else if (fb < DIN)  store_strip_rows<true>(acc, (u16*)(ws + OFF_GATE), 2048, 1024 + fb - 4928, tok0, rs, r32, h, lds, wid, lane);
}

DI void p2_q_tile(const Params& p, int tm, int tn, char* lds) {
  unsigned char* ws = p.ws;
  const int wid = __builtin_amdgcn_readfirstlane(fresh_tid() >> 6), wr = wid >> 1, wc = wid & 1;
  const int m0 = tm * GM, n0 = tn * GN, tok0 = m0 + wr * 128;
  f32x16 acc[4][2];
  gemm_mainloop<false>(acc, (const u16*)(ws + OFF_CQ), S, (const u16*)(ws + OFF_WQT), 1536, 512, m0, n0, lds);
  const int lane = fresh_tid() & 63, r32 = lane & 31, h = lane >> 5;
  const float* ssq = (const float*)(ws + OFF_CQSS);
  float rs[4];
#pragma unroll
  for (int mt = 0; mt < 4; ++mt) {
    const f32x4 a = *(const f32x4*)(ssq + (size_t)(tok0 + mt * 32 + r32) * 8), b = *(const f32x4*)(ssq + (size_t)(tok0 + mt * 32 + r32) * 8 + 4);
    rs[mt] = rsqrtf(((a[0] + a[1]) + (a[2] + a[3]) + (b[0] + b[1]) + (b[2] + b[3])) * (1.f / 512.f) + EPS);
  }
  const int fb = n0 + wc * 64;
  if ((fb % 192) == 128) store_rope_strip(acc, (u16*)(ws + OFF_QMLA), 1536, fb, tok0, rs, r32, h, (const float*)(ws + OFF_COS), (const float*)(ws + OFF_SIN));
  else                   store_strip_rows<false>(acc, (u16*)(ws + OFF_QMLA), 1536, fb, tok0, rs, r32, h, lds, wid, lane);
}
DI float kv_rstd(const float* sskv, int tok) { const f32x4 a = *(const f32x4*)(sskv + (size_t)tok * 4); return rsqrtf(((a[0] + a[1]) + (a[2] + a[3])) * (1.f / 256.f) + EPS); }
DI void p2_kv_tile(const Params& p, int tm, int tn, char* lds) {
  unsigned char* ws = p.ws;
  const int wid = __builtin_amdgcn_readfirstlane(fresh_tid() >> 6), wr = wid >> 1, wc = wid & 1;
  const int m0 = tm * GM, n0 = tn * GN, tok0 = m0 + wr * 128, hd = n0 >> 8;
  const float* sskv = (const float*)(ws + OFF_CKVSS);
  f32x16 acc[4][2];
  if (n0 & 128) {
    gemm_mainloop<true>(acc, (const u16*)(ws + OFF_CKV), S, (const u16*)(ws + OFF_WKVT), 2048, 256, m0, n0, lds);
    const int lane = fresh_tid() & 63, r32 = lane & 31, h = lane >> 5;
    store_strip_T<true>(acc, (u16*)(ws + OFF_MVT), hd * 128 + wc * 64, tok0, sskv, r32, h);
  } else {
    gemm_mainloop<false>(acc, (const u16*)(ws + OFF_CKV), S, (const u16*)(ws + OFF_WKVT), 2048, 256, m0, n0, lds);
    const int lane = fresh_tid() & 63, r32 = lane & 31, h = lane >> 5;
    float rs[4];
#pragma unroll
    for (int mt = 0; mt < 4; ++mt) rs[mt] = kv_rstd(sskv, tok0 + mt * 32 + r32);
    store_strip_rows<false>(acc, (u16*)(ws + OFF_KNOPE), 1024, hd * 128 + wc * 64, tok0, rs, r32, h, lds, wid, lane);
  }
}

DI void p4_tile(const Params& p, int tm, int tn, char* lds) {
  unsigned char* ws = p.ws;
  const int wid = __builtin_amdgcn_readfirstlane(fresh_tid() >> 6), wr = wid >> 1, wc = wid & 1;
  const int m0 = tm * GM, n0 = tn * GN, tok0 = m0 + wr * 128;
  f32x16 acc[4][2];
  gemm_mainloop<false>(acc, (const u16*)(ws + OFF_MIXED), S, (const u16*)(ws + OFF_WOT), 2048, 2048, m0, n0, lds);
  const int lane = fresh_tid() & 63, r32 = lane & 31, h = lane >> 5;
  const int fb = n0 + wc * 64;
  const float one[4] = {1.f, 1.f, 1.f, 1.f};
  store_strip_rows<false>(acc, (u16*)(ws + OFF_Y), 2048, fb, tok0, one, r32, h, lds, wid, lane);
  strip_sumsq(acc, (float*)(ws + OFF_YSS), 32, fb >> 6, tok0, one, r32, h);
}

constexpr int SB_VT = 24576, LDS_MISC = 40960;
constexpr int MLA_KN = 0, MLA_KR = 32768, MLA_VT = 49152;

DI void vt_load(u32x4 (&vreg)[4], const u16* VT, int head, int key0, int tid) {
  const char* base = (const char*)(VT + (size_t)(head * 128) * S + key0);
  const unsigned voff = (unsigned)(((tid >> 3) * S + (tid & 7) * 8) * 2);
#pragma unroll
  for (int i = 0; i < 4; ++i) vreg[i] = *(const u32x4*)(base + (size_t)(32 * i) * S * 2 + voff);
}
template <int LDS_VT>
DI void vt_write(const u32x4 (&vreg)[4], char* lds, int tid) {
  const int d = tid >> 3, c = tid & 7, sw = (d >> 1) & 7;
  char* b0 = lds + LDS_VT + d * 128 + ((c ^ sw) << 4);
#pragma unroll
  for (int i = 0; i < 4; ++i) *(u32x4*)(b0 + i * 4096) = vreg[i];
}
template <int LDS_VT>
DI void pv_tile(f32x16 (&o)[4], const bf16x8 (&pf)[2][2], const char* lds, int r32, int h) {
  const int sw = (r32 >> 1) & 7;
  const unsigned base = (unsigned)(size_t)(lds + LDS_VT + r32 * 128);
  unsigned adr[4];
#pragma unroll
  for (int k = 0; k < 4; ++k) adr[k] = base + (((2 * k + h) ^ sw) << 4);
  bf16x8 vf[4];
#define PV_READ(q) do { switch ((q) >> 2) { \
    case 0: ds_rd128<0>(vf[(q) & 3], adr[(q) & 3]); break; \
    case 1: ds_rd128<4096>(vf[(q) & 3], adr[(q) & 3]); break; \
    case 2: ds_rd128<8192>(vf[(q) & 3], adr[(q) & 3]); break; \
    default: ds_rd128<12288>(vf[(q) & 3], adr[(q) & 3]); break; } } while (0)
  PV_READ(0); PV_READ(1); PV_READ(2);
#pragma unroll
  for (int q = 0; q < 16; ++q) {
    if (q + 3 < 16) PV_READ(q + 3);
    if (q + 3 < 16) lgkm_wait1<3>(vf[q & 3]); else if (q + 2 < 16) lgkm_wait1<2>(vf[q & 3]); else if (q + 1 < 16) lgkm_wait1<1>(vf[q & 3]); else lgkm_wait1<0>(vf[q & 3]);
    o[q >> 2] = MFMA(vf[q & 3], pf[(q >> 1) & 1][q & 1], o[q >> 2]);
  }
#undef PV_READ
}
DI bf16x8 pack8(const f32x16& x, int s2) {
  const u32x4 w = {pack2(x[8 * s2], x[8 * s2 + 1]), pack2(x[8 * s2 + 2], x[8 * s2 + 3]), pack2(x[8 * s2 + 4], x[8 * s2 + 5]), pack2(x[8 * s2 + 6], x[8 * s2 + 7])};
  return __builtin_bit_cast(bf16x8, w);
}
DI void attn_store(const f32x16 (&o)[4], float scale, const u16* gate, u16* mixed, int tok, int col0, int h) {
  const u16* gp = gate + (size_t)tok * 2048 + col0 + 4 * h;
  u16* op = mixed + kblk(S, tok, col0) + 8 * h;
#pragma unroll
  for (int dt = 0; dt < 4; ++dt)
#pragma unroll
    for (int k = 0; k < 2; ++k) {
      u32x2 pk[2];
#pragma unroll
      for (int e = 0; e < 2; ++e) {
        const int g = 2 * k + e;
        const u32x2 gw = *(const u32x2*)(gp + dt * 32 + 8 * g);
        pk[e][0] = pack2(o[dt][4 * g] * scale * bflo(gw[0]), o[dt][4 * g + 1] * scale * bfhi(gw[0]));
        pk[e][1] = pack2(o[dt][4 * g + 2] * scale * bflo(gw[1]), o[dt][4 * g + 3] * scale * bfhi(gw[1]));
      }
      *(u32x4*)(op + (size_t)dt * S * 32 + 16 * k) = widen16(pk[0], pk[1]);
    }
}

DI void mla_item(const Params& p, int head, int qb, int t0, int t1, int mode, int pr, char* lds) {
  unsigned char* ws = p.ws;
  const int tid = fresh_tid(), wid = __builtin_amdgcn_readfirstlane(tid >> 6), lane = tid & 63, r32 = lane & 31, h = lane >> 5;
  const u16* Q = (const u16*)(ws + OFF_QMLA); const u16* KN = (const u16*)(ws + OFF_KNOPE); const u16* KR = (const u16*)(ws + OFF_KROT); const u16* VT = (const u16*)(ws + OFF_MVT);
  const int tok = qb * 128 + wid * 32 + r32;
  bf16x8 qf[12];
#pragma unroll
  for (int ks = 0; ks < 12; ++ks) qf[ks] = *(const bf16x8*)(Q + (size_t)tok * 1536 + head * 192 + ks * 16 + h * 8);
  f32x16 o[4];
#pragma unroll
  for (int dt = 0; dt < 4; ++dt)
#pragma unroll
    for (int r = 0; r < 16; ++r) o[dt][r] = 0.f;
  float m = -1e30f, l = 0.f;
  const int mynt = 2 * qb + 1 + (wid >> 1);
  constexpr float C = 0.07216878364870323f * 1.4426950408889634f;
  constexpr float MLA_THR = 8.f * 1.4426950408889634f;
  u32x4 vreg[4];
  const int knr = wid * 4 + (lane >> 4), krr = wid * 8 + (lane >> 3);
  const unsigned kn_off = (unsigned)((knr * 1024 + (((lane & 15) ^ (knr & 15)) * 8)) * 2);
  const unsigned kr_off = (unsigned)((krr * 64 + (((lane & 7) ^ ((krr >> 1) & 7)) * 8)) * 2);
  const unsigned v_off = (unsigned)(((tid >> 3) * S + (tid & 7) * 8) * 2);
#define STAGE_PIECE(i, tn) do { \
    if ((i) < 4) dma16((const char*)(KN + (size_t)(tn) * 64 * 1024 + head * 128) + kn_off + (i) * 32768, lds + MLA_KN + ((tn) & 1) * 16384 + wid * 1024 + (i) * 4096); \
    else if ((i) < 6) dma16((const char*)(KR + (size_t)(tn) * 64 * 64) + kr_off + ((i) - 4) * 4096, lds + MLA_KR + ((tn) & 1) * 8192 + wid * 1024 + ((i) - 4) * 4096); \
    else vreg[(i) - 6] = *(const u32x4*)((const char*)(VT + (size_t)(head * 128) * S + (size_t)(tn) * 64) + (size_t)(32 * ((i) - 6)) * S * 2 + v_off); } while (0)
  __syncthreads();
#pragma unroll
  for (int i = 0; i < 10; ++i) STAGE_PIECE(i, t0);
  const int sw16 = r32 & 15, sw8 = (r32 >> 1) & 7;
  const int swv = (r32 >> 1) & 7;
  const unsigned vbase = (unsigned)(size_t)(lds + MLA_VT + r32 * 128);
  unsigned adrv[4];
#pragma unroll
  for (int k = 0; k < 4; ++k) adrv[k] = vbase + (((2 * k + h) ^ swv) << 4);
  for (int t = t0; t < t1; ++t) {
    __syncthreads();
    vt_write<MLA_VT>(vreg, lds, tid);
    asm volatile("s_waitcnt vmcnt(0)" ::: "memory");
    __syncthreads();
    const bool more = t + 1 < t1;
    if (t < mynt) {
      const unsigned knu = (unsigned)(size_t)(lds + MLA_KN + (t & 1) * 16384 + r32 * 256);
      const unsigned kru = (unsigned)(size_t)(lds + MLA_KR + (t & 1) * 8192 + r32 * 128);
      f32x16 sa, sb;
#pragma unroll
      for (int r = 0; r < 16; ++r) { sa[r] = 0.f; sb[r] = 0.f; }
      bf16x8 kf[3];
      bf16x8 vf[4];
      bf16x8 pfa[2], pfb[2];
      float mx1 = 0.f, alpha = 1.f, negm = 0.f, ps = 0.f;
#define K_READ(j) do { const int ks_ = (j) % 12; \
        if (ks_ < 8) { const unsigned a_ = knu + (((2 * ks_ + h) ^ sw16) << 4); if ((j) >= 12) ds_rd128<8192>(kf[(j) % 3], a_); else ds_rd128<0>(kf[(j) % 3], a_); } \
        else { const unsigned a_ = kru + (((2 * (ks_ - 8) + h) ^ sw8) << 4); if ((j) >= 12) ds_rd128<4096>(kf[(j) % 3], a_); else ds_rd128<0>(kf[(j) % 3], a_); } } while (0)
#define V_READ(n) do { const int k_ = ((n) >> 3) * 2 + ((n) & 1); switch (((n) >> 1) & 3) { \
        case 0: ds_rd128<0>(vf[(n) & 3], adrv[k_]); break; \
        case 1: ds_rd128<4096>(vf[(n) & 3], adrv[k_]); break; \
        case 2: ds_rd128<8192>(vf[(n) & 3], adrv[k_]); break; \
        default: ds_rd128<12288>(vf[(n) & 3], adrv[k_]); break; } } while (0)
      K_READ(0); K_READ(1);
#pragma unroll
      for (int ks = 0; ks < 12; ++ks) {
        K_READ(ks + 2);
        lgkm_wait1<2>(kf[ks % 3]);
        sa = MFMA(kf[ks % 3], qf[ks], sa);
        if (more && ks < 10) STAGE_PIECE(ks, t + 1);
        __builtin_amdgcn_sched_barrier(0);
      }
#pragma unroll
      for (int ks = 0; ks < 12; ++ks) {
        if (ks < 10) K_READ(12 + ks + 2); else if (ks == 10) V_READ(0); else { V_READ(1); V_READ(2); }
        if (ks < 10) lgkm_wait1<2>(kf[ks % 3]); else if (ks == 10) lgkm_wait1<2>(kf[ks % 3]); else lgkm_wait1<3>(kf[ks % 3]);
        sb = MFMA(kf[ks % 3], qf[ks], sb);
        if (ks == 0) { mx1 = vmax3(vmax3(vmax3_first(sa[0], sa[1], sa[2]), sa[3], sa[4]), sa[5], sa[6]); }
        else if (ks == 1) { mx1 = vmax3(vmax3(vmax3(vmax3(mx1, sa[7], sa[8]), sa[9], sa[10]), sa[11], sa[12]), sa[13], sa[14]); mx1 = fmaxf(mx1, sa[15]); }
        else if (ks == 2) { const float mx = xhalf_max(mx1) * C;     if (__all(mx - m <= MLA_THR)) { alpha = 1.f; } else { const float mnew = fmaxf(m, mx); alpha = __builtin_amdgcn_exp2f(m - mnew); m = mnew; } negm = -m; }
        else if (ks == 3) { if (!__all(alpha == 1.f)) {
#pragma unroll
            for (int dt = 0; dt < 4; ++dt)
#pragma unroll
              for (int r = 0; r < 16; ++r) o[dt][r] *= alpha; } }
        else if (ks < 8) {
#pragma unroll
          for (int i = 0; i < 4; ++i) sa[4 * (ks - 4) + i] = __builtin_amdgcn_exp2f(fmaf(sa[4 * (ks - 4) + i], C, negm)); }
        else if (ks == 8) { ps = ((sa[0] + sa[1]) + (sa[2] + sa[3])) + ((sa[4] + sa[5]) + (sa[6] + sa[7])) + (((sa[8] + sa[9]) + (sa[10] + sa[11])) + ((sa[12] + sa[13]) + (sa[14] + sa[15]))); }
        else if (ks == 9) { l = l * alpha + ps; }
        else if (ks == 10) pfa[0] = pack8(sa, 0);
        else pfa[1] = pack8(sa, 1);
        __builtin_amdgcn_sched_barrier(0);
      }
#pragma unroll
      for (int q = 0; q < 8; ++q) {
        V_READ(q + 3);
        lgkm_wait1<3>(vf[q & 3]);
        o[q >> 1] = MFMA(vf[q & 3], pfa[q & 1], o[q >> 1]);
        if (q == 0) { mx1 = vmax3(vmax3(vmax3_first(sb[0], sb[1], sb[2]), sb[3], sb[4]), sb[5], sb[6]); }
        else if (q == 1) { mx1 = vmax3(vmax3(vmax3(vmax3(mx1, sb[7], sb[8]), sb[9], sb[10]), sb[11], sb[12]), sb[13], sb[14]); mx1 = fmaxf(mx1, sb[15]);
                           const float mx = xhalf_max(mx1) * C;     if (__all(mx - m <= MLA_THR)) { alpha = 1.f; } else { const float mnew = fmaxf(m, mx); alpha = __builtin_amdgcn_exp2f(m - mnew); m = mnew; } negm = -m; }
        else if (q < 6) {
#pragma unroll
          for (int i = 0; i < 4; ++i) sb[4 * (q - 2) + i] = __builtin_amdgcn_exp2f(fmaf(sb[4 * (q - 2) + i], C, negm)); }
        else if (q == 6) { ps = ((sb[0] + sb[1]) + (sb[2] + sb[3])) + ((sb[4] + sb[5]) + (sb[6] + sb[7])) + (((sb[8] + sb[9]) + (sb[10] + sb[11])) + ((sb[12] + sb[13]) + (sb[14] + sb[15]))); l = l * alpha + ps; }
        else { pfb[0] = pack8(sb, 0); pfb[1] = pack8(sb, 1); }
        __builtin_amdgcn_sched_barrier(0);
      }
      if (!__all(alpha == 1.f)) {
#pragma unroll
        for (int dt = 0; dt < 4; ++dt)
#pragma unroll
          for (int r = 0; r < 16; ++r) o[dt][r] *= alpha;
      }
      __builtin_amdgcn_sched_barrier(0);
#pragma unroll
      for (int q = 8; q < 16; ++q) {
        if (q + 3 < 16) V_READ(q + 3);
        if (q + 3 < 16) lgkm_wait1<3>(vf[q & 3]); else if (q + 2 < 16) lgkm_wait1<2>(vf[q & 3]); else if (q + 1 < 16) lgkm_wait1<1>(vf[q & 3]); else lgkm_wait1<0>(vf[q & 3]);
          o[(q >> 1) & 3] = MFMA(vf[q & 3], pfb[q & 1], o[(q >> 1) & 3]);
        __builtin_amdgcn_sched_barrier(0);
      }
#undef K_READ
#undef V_READ
    } else if (more) {
#pragma unroll
      for (int i = 0; i < 10; ++i) STAGE_PIECE(i, t + 1);
    }
  }
#undef STAGE_PIECE
  int tok2 = tok; asm volatile("" : "+v"(tok2));
  float* part = (float*)(ws + OFF_PART + (size_t)pr * PART_STRIDE);
  unsigned* flag = (unsigned*)(ws + OFF_FLAG) + pr;
  if (mode == 1) {
#pragma unroll
    for (int dt = 0; dt < 4; ++dt)
#pragma unroll
      for (int r = 0; r < 16; ++r) part[(dt * 16 + r) * 256 + tid] = o[dt][r];
    part[16384 + tid] = m; part[16384 + 256 + tid] = l;
    asm volatile("s_waitcnt vmcnt(0)" ::: "memory");
    __syncthreads();
    if (tid == 0) {
      __builtin_amdgcn_fence(__ATOMIC_RELEASE, "agent");
      asm volatile("s_waitcnt vmcnt(0)" ::: "memory");
      __hip_atomic_store(flag, 1u, __ATOMIC_RELAXED, __HIP_MEMORY_SCOPE_AGENT);
    }
    return;
  }
  if (mode == 2) {
    if (tid == 0) {
      unsigned sp = 0;
      while (__hip_atomic_load(flag, __ATOMIC_RELAXED, __HIP_MEMORY_SCOPE_AGENT) == 0u) { __builtin_amdgcn_s_sleep(2); if (++sp > (1u << 22)) break; }
      __builtin_amdgcn_fence(__ATOMIC_ACQUIRE, "agent");
      asm volatile("s_waitcnt vmcnt(0)" ::: "memory");
    }
    __syncthreads();
    const float mb = part[16384 + tid], lb = part[16384 + 256 + tid];
    const float mm = fmaxf(m, mb), fa = __builtin_amdgcn_exp2f(m - mm), fb = __builtin_amdgcn_exp2f(mb - mm);
    l = l * fa + lb * fb;
#pragma unroll
    for (int dt = 0; dt < 4; ++dt)
#pragma unroll
      for (int r = 0; r < 16; ++r) o[dt][r] = o[dt][r] * fa + part[(dt * 16 + r) * 256 + tid] * fb;
  }
  l = xhalf_sum(l);
  attn_store(o, 1.f / l, (const u16*)(ws + OFF_GATE), (u16*)(ws + OFF_MIXED), tok2, 1024 + head * 128, h);
}

constexpr float SB_DONE = -120.f;
DI void sb_block32(f32x16& s, float& c, int key0, int tok, int h) {
  constexpr float SC = 0.08838834764831845f;
  float lk[16];
#pragma unroll
  for (int r = 0; r < 16; ++r) {
    const int key = key0 + (r & 3) + 8 * (r >> 2) + 4 * h;
    const float z = s[r] * SC;
    const float sp = fmaxf(z, 0.f) + __logf(1.f + __expf(-fabsf(z)));
    const bool valid = key < tok;
    lk[r] = valid ? -sp : 0.f;
    s[r] = valid ? (z - sp) : -1e30f;
  }
  float G[4], PG[4], T[4];
#pragma unroll
  for (int g = 0; g < 4; ++g) { G[g] = (lk[4 * g] + lk[4 * g + 1]) + (lk[4 * g + 2] + lk[4 * g + 3]); PG[g] = xhalf_other(G[g], h); T[g] = G[g] + PG[g]; }
  float ST[4]; ST[3] = 0.f; ST[2] = T[3]; ST[1] = T[3] + T[2]; ST[0] = ST[1] + T[1];
  const float total = ST[0] + T[0];
#pragma unroll
  for (int g = 0; g < 4; ++g) {
    const float base = c + ST[g] + (h == 0 ? PG[g] : 0.f);
    const float l3 = base, l2 = l3 + lk[4 * g + 3], l1 = l2 + lk[4 * g + 2], l0 = l1 + lk[4 * g + 1];
    s[4 * g + 3] = __expf(s[4 * g + 3] + l3); s[4 * g + 2] = __expf(s[4 * g + 2] + l2);
    s[4 * g + 1] = __expf(s[4 * g + 1] + l1); s[4 * g]     = __expf(s[4 * g] + l0);
  }
  c += total;
}
DI void sb_item(const Params& p, int head, int qb, char* lds) {
  unsigned char* ws = p.ws;
  const int tid = fresh_tid(), wid = __builtin_amdgcn_readfirstlane(tid >> 6), lane = tid & 63, r32 = lane & 31, h = lane >> 5;
  const u16* Q = (const u16*)(ws + OFF_SBQ); const u16* Kg = (const u16*)(ws + OFF_SBK); const u16* VT = (const u16*)(ws + OFF_SBVT);
  const int tok = qb * 128 + wid * 32 + r32, tokmax = qb * 128 + wid * 32 + 31;
  unsigned qoff = (unsigned)((tok * 1024 + head * 128 + h * 8) * 2);
  f32x16 o[4];
#pragma unroll
  for (int dt = 0; dt < 4; ++dt)
#pragma unroll
    for (int r = 0; r < 16; ++r) o[dt][r] = 0.f;
  float c = 0.f; int wdone = 0;
  u32x4 kreg[4], vreg[4];
  const int srow = tid >> 3, sc = tid & 7;
  const unsigned k_off = (unsigned)((srow * 1024 + sc * 8) * 2);
  char* kw = lds + srow * 256 + ((sc ^ (srow & 15)) << 4);
#define K_LOAD(t) do { const char* a_ = (const char*)(Kg + (size_t)(t) * 64 * 1024 + head * 128); kreg[0] = *(const u32x4*)(a_ + k_off); kreg[1] = *(const u32x4*)(a_ + 128 + k_off); \
    kreg[2] = *(const u32x4*)(a_ + 32 * 2048 + k_off); kreg[3] = *(const u32x4*)(a_ + 32 * 2048 + 128 + k_off); } while (0)
#define K_WRITE() do { char* kw2_ = (char*)((size_t)kw ^ 128); *(u32x4*)(kw) = kreg[0]; *(u32x4*)(kw2_) = kreg[1]; \
    *(u32x4*)(kw + 32 * 256) = kreg[2]; *(u32x4*)(kw2_ + 32 * 256) = kreg[3]; } while (0)
  const int T0 = 2 * qb + 1;
  K_LOAD(T0); vt_load(vreg, VT, head, T0 * 64, tid);
  volatile int* flags = (volatile int*)(lds + LDS_MISC + 16);
  const char* kb0 = lds + r32 * 256;
  const int sw = r32 & 15;
  for (int t = T0; t >= 0; --t) {
    if (lane == 0) flags[wid] = wdone;
    __syncthreads();
    if (flags[0] & flags[1] & flags[2] & flags[3]) break;
    K_WRITE(); vt_write<SB_VT>(vreg, lds, tid);
    __syncthreads();
    bf16x8 pf[2][2];
    const bool act = (t * 64 < tokmax) && !wdone;
    if (act) {
      bf16x8 qf[8];
      asm volatile("" : "+v"(qoff));
#pragma unroll
      for (int ks = 0; ks < 8; ++ks) qf[ks] = *(const bf16x8*)((const char*)Q + qoff + ks * 32);
      {
        f32x16 s1;
#pragma unroll
        for (int r = 0; r < 16; ++r) s1[r] = 0.f;
#pragma unroll
        for (int ks = 0; ks < 8; ++ks) s1 = MFMA(*(const bf16x8*)(kb0 + 32 * 256 + (((2 * ks + h) ^ sw) << 4)), qf[ks], s1);
        sb_block32(s1, c, t * 64 + 32, tok, h);
        pf[1][0] = pack8(s1, 0); pf[1][1] = pack8(s1, 1);
      }
      __builtin_amdgcn_sched_barrier(0);
      {
        f32x16 s0;
#pragma unroll
        for (int r = 0; r < 16; ++r) s0[r] = 0.f;
#pragma unroll
        for (int ks = 0; ks < 8; ++ks) s0 = MFMA(*(const bf16x8*)(kb0 + (((2 * ks + h) ^ sw) << 4)), qf[ks], s0);
        sb_block32(s0, c, t * 64, tok, h);
        pf[0][0] = pack8(s0, 0); pf[0][1] = pack8(s0, 1);
      }
    }
    if (t > 0) { K_LOAD(t - 1); vt_load(vreg, VT, head, (t - 1) * 64, tid); }
    if (act) { pv_tile<SB_VT>(o, pf, lds, r32, h); wdone = __all(c < SB_DONE) ? 1 : 0; }
  }
#undef K_LOAD
#undef K_WRITE
  int tok2 = tok; asm volatile("" : "+v"(tok2));
  attn_store(o, 1.f, (const u16*)(ws + OFF_GATE), (u16*)(ws + OFF_MIXED), tok2, head * 128, h);
}

struct TDesc { const float* src; const float* scale; u16* dst; int K, N, k0, n0, rows; };
DI TDesc tile_desc(const Params& p, int t) {
  constexpr int T_IN = 32 * 94, T_OUT = 32 * 32, T_Q = 8 * 24;
  unsigned char* ws = p.ws; TDesc d;
  if (t < T_IN) { const int kt = t / 94, nt = t - kt * 94; d = {p.w_in, p.pre_w, (u16*)(ws + OFF_WINT), DM, DIN, kt * 64, nt * 64, DINP}; }
  else if (t < T_IN + T_OUT) { const int u = t - T_IN; d = {p.w_out, nullptr, (u16*)(ws + OFF_WOT), 2048, 2048, (u >> 5) * 64, (u & 31) * 64, 2048}; }
  else if (t < T_IN + T_OUT + T_Q) { const int u = t - T_IN - T_OUT, kt = u / 24, nt = u - kt * 24; d = {p.w_qup, p.qn_w, (u16*)(ws + OFF_WQT), 512, 1536, kt * 64, nt * 64, 1536}; }
  else { const int u = t - T_IN - T_OUT - T_Q; d = {p.w_kvup, p.kvn_w, (u16*)(ws + OFF_WKVT), 256, 2048, (u >> 5) * 64, (u & 31) * 64, 2048}; }
  return d;
}
DI void tr_load(f32x4 (&reg)[4], float (&sc)[4], const TDesc& d, int tid) {
#pragma unroll
  for (int i = 0; i < 4; ++i) {
    const int idx = tid + 256 * i, kk = idx >> 4, n4 = (idx & 15) * 4;
    if (d.n0 < d.N) { reg[i] = *(const f32x4*)(d.src + (size_t)(d.k0 + kk) * d.N + d.n0 + n4); sc[i] = d.scale ? d.scale[d.k0 + kk] : 1.f; }
    else { reg[i] = f32x4{0.f, 0.f, 0.f, 0.f}; sc[i] = 0.f; }
  }
}
DI void phase0(const Params& p, char* lds) {
  unsigned char* ws = p.ws;
  const int tid = fresh_tid(), wid = __builtin_amdgcn_readfirstlane(tid >> 6), lane = tid & 63, nb = gridDim.x, bid = blockIdx.x;
  if (bid == 0) { unsigned* ctr = (unsigned*)(ws + OFF_CTR); if (tid < 16) ctr[tid] = 0u; ((unsigned*)(ws + OFF_FLAG))[tid] = 0u; }
  {
    constexpr int NT = 32 * 94 + 32 * 32 + 8 * 24 + 4 * 32;
    float* tl = (float*)lds;
    f32x4 reg[4]; float sc[4];
    int t = bid; TDesc d = tile_desc(p, t < NT ? t : 0);
    if (t < NT) tr_load(reg, sc, d, tid);
    while (t < NT) {
      __syncthreads();
#pragma unroll
      for (int i = 0; i < 4; ++i) {
        const int idx = tid + 256 * i, kk = idx >> 4, n4 = (idx & 15) * 4;
#pragma unroll
        for (int j = 0; j < 4; ++j) tl[kk * 65 + n4 + j] = reg[i][j] * sc[i];
      }
      __syncthreads();
      const TDesc dc = d;
      const int tn = t + nb;
      if (tn < NT) { d = tile_desc(p, tn); tr_load(reg, sc, d, tid); }
#pragma unroll
      for (int i = 0; i < 2; ++i) {
        const int idx = tid + 256 * i, nn = idx >> 3, m = idx & 7;
        const float* c0 = tl + (8 * m) * 65 + nn;
        u32x4 w = {pack2(c0[0], c0[65]), pack2(c0[130], c0[195]), pack2(c0[260], c0[325]), pack2(c0[390], c0[455])};
        *(u32x4*)(dc.dst + kblk(dc.rows, dc.n0 + nn, dc.k0 + 8 * m)) = w;
      }
      t = tn;
    }
  }
  float* COS = (float*)(ws + OFF_COS); float* SIN = (float*)(ws + OFF_SIN);
  for (int idx = bid * 256 + tid; idx < S * 32; idx += nb * 256) {
    const int tok = idx >> 5, i = idx & 31;
    const float inv = exp2f(-(float)i * (13.287712379549449f / 32.f));
    const float ang = (float)p.pos[tok] * inv;
    const double a = (double)ang * 0.15915494309189535;
    const float rev = (float)(a - rint(a));
    COS[idx] = __builtin_amdgcn_cosf(rev); SIN[idx] = __builtin_amdgcn_sinf(rev);
  }
  u16* XB = (u16*)(ws + OFF_XB); float* rstdx = (float*)(ws + OFF_RSTDX);
  for (int row = (bid * 4 + wid) * 2; row < S; row += nb * 8) {
    const f32x4* xr = (const f32x4*)(p.x + (size_t)row * DM);
    f32x4 v[16]; float ss0 = 0.f, ss1 = 0.f;
#pragma unroll
    for (int i = 0; i < 16; ++i) v[i] = xr[lane + 64 * i];
#pragma unroll
    for (int i = 0; i < 8; ++i) { ss0 += v[i][0] * v[i][0] + v[i][1] * v[i][1] + v[i][2] * v[i][2] + v[i][3] * v[i][3]; ss1 += v[i + 8][0] * v[i + 8][0] + v[i + 8][1] * v[i + 8][1] + v[i + 8][2] * v[i + 8][2] + v[i + 8][3] * v[i + 8][3]; }
    ss0 = wave_sum(ss0, lane); ss1 = wave_sum(ss1, lane);
    if (lane == 0) { rstdx[row] = rsqrtf(ss0 * (1.f / 2048.f) + EPS); rstdx[row + 1] = rsqrtf(ss1 * (1.f / 2048.f) + EPS); }
#pragma unroll
    for (int i = 0; i < 16; ++i) store4bf(XB + kblk(S, row + (i >> 3), ((lane + 64 * i) * 4) & 2047), v[i][0], v[i][1], v[i][2], v[i][3]);
  }
}

DI void phase5(const Params& p) {
  const int tid = fresh_tid(), wid = __builtin_amdgcn_readfirstlane(tid >> 6), lane = tid & 63, nb = gridDim.x, bid = blockIdx.x;
  const float* yss = (const float*)(p.ws + OFF_YSS); const u16* Y = (const u16*)(p.ws + OFF_Y);
  f32x4 w[8];
#pragma unroll
  for (int i = 0; i < 8; ++i) w[i] = ((const f32x4*)p.post_w)[lane + 64 * i];
  for (int row = (bid * 4 + wid) * 2; row < S; row += nb * 8) {
    const f32x4* xr = (const f32x4*)(p.x + (size_t)row * DM);
    const u32x2* yr = (const u32x2*)(Y + (size_t)row * DM);
    f32x4 xv[16]; u32x2 yv[16];
#pragma unroll
    for (int i = 0; i < 16; ++i) { xv[i] = xr[lane + 64 * i]; yv[i] = yr[lane + 64 * i]; }
    const float s0 = wave_sum(lane < 32 ? yss[(size_t)row * 32 + lane] : 0.f, lane), s1 = wave_sum(lane < 32 ? yss[(size_t)(row + 1) * 32 + lane] : 0.f, lane);
    const float rs0 = rsqrtf(s0 * (1.f / 2048.f) + EPS), rs1 = rsqrtf(s1 * (1.f / 2048.f) + EPS);
    f32x4* orow = (f32x4*)(p.out + (size_t)row * DM);
#pragma unroll
    for (int i = 0; i < 16; ++i) {
      const float rs = i < 8 ? rs0 : rs1; const f32x4 ww = w[i & 7];
      f32x4 r = {xv[i][0] + bflo(yv[i][0]) * rs * ww[0], xv[i][1] + bfhi(yv[i][0]) * rs * ww[1], xv[i][2] + bflo(yv[i][1]) * rs * ww[2], xv[i][3] + bfhi(yv[i][1]) * rs * ww[3]};
      orow[lane + 64 * i] = r;
    }
  }
}

#define XB_TMO      128
#define XB_XCNT(j)  (256  + 64 * (j))
#define XB_XSUB(j)  (1280 + 64 * (j))
#define XB_XGEN(j)  (2304 + 64 * (j))
#define XB_TOP      3328
#define XB_TOPGEN   3392
#define XCD_BAR_WORDS 3456
#define XB_SPIN_CAP (1u << 20)
#define LAS __attribute__((address_space(3)))
DI unsigned xb_ld(unsigned* p)              { return __hip_atomic_load(p, __ATOMIC_RELAXED, __HIP_MEMORY_SCOPE_AGENT); }
DI unsigned xb_add(unsigned* p, unsigned v) { return __hip_atomic_fetch_add(p, v, __ATOMIC_RELAXED, __HIP_MEMORY_SCOPE_AGENT); }
DI unsigned xb_xcc_id() { return (unsigned)__builtin_amdgcn_s_getreg((3 << 11) | 20) & 0xFu; }
#define XB_SPIN(cond, bar) do { unsigned _sp = 0; while (cond) { __builtin_amdgcn_s_sleep(1); \
    if ((++_sp & 255u) == 0u) { if (xb_ld(&(bar)[XB_TMO])) break; if (_sp > XB_SPIN_CAP) { atomicAdd(&(bar)[XB_TMO], 1u); break; } } } } while (0)
struct XcdBarrier { unsigned* bar; unsigned x; volatile LAS unsigned* st; };
DI XcdBarrier xcd_barrier_post(unsigned* bar, volatile LAS unsigned* st) {
  XcdBarrier b; b.bar = bar; b.x = xb_xcc_id(); b.st = st;
  if (threadIdx.x == 0) (void)xb_add(&bar[XB_XCNT(b.x)], 1u);
  return b;
}
DI void xcd_barrier_complete(unsigned* bar, unsigned x, unsigned& nloc, unsigned& nx) {
  const unsigned G = gridDim.x * gridDim.y * gridDim.z;
  unsigned sum, cnt, mine, sp = 0u;
  for (;;) {
    sum = 0u; cnt = 0u; mine = 0u;
#pragma unroll
    for (unsigned j = 0; j < 16; ++j) { const unsigned c = xb_ld(&bar[XB_XCNT(j)]); sum += c; cnt += (c > 0u) ? 1u : 0u; mine = (j == x) ? c : mine; }
    if (sum == G) break;
    __builtin_amdgcn_s_sleep(1);
    if ((++sp & 255u) == 0u) { if (xb_ld(&bar[XB_TMO])) break; if (sp > XB_SPIN_CAP) { atomicAdd(&bar[XB_TMO], 1u); break; } }
  }
  nloc = mine > 0u ? mine : 1u; nx = cnt > 0u ? cnt : 1u;
}
DI void xcd_barrier(const XcdBarrier& b) {
  asm volatile("s_waitcnt vmcnt(0)" ::: "memory");
  __syncthreads();
  if (threadIdx.x == 0) {
    unsigned* bar = b.bar;
    __builtin_amdgcn_s_waitcnt(0);
    unsigned nloc = b.st[0], nx = b.st[1];
    if (nloc == 0u) { xcd_barrier_complete(bar, b.x, nloc, nx); b.st[0] = nloc; b.st[1] = nx; }
    const unsigned old = xb_add(&bar[XB_XSUB(b.x)], 1u);
    const unsigned gen = old / nloc;
    if (old + 1u == (gen + 1u) * nloc) {
      __builtin_amdgcn_fence(__ATOMIC_RELEASE, "agent");
      asm volatile("s_waitcnt vmcnt(0)" ::: "memory");
      const unsigned og = xb_add(&bar[XB_TOP], 1u);
      const unsigned tg = og / nx;
      if (og + 1u == (tg + 1u) * nx) xb_add(&bar[XB_TOPGEN], 1u);
      else XB_SPIN(xb_ld(&bar[XB_TOPGEN]) == tg, bar);
      __builtin_amdgcn_fence(__ATOMIC_ACQUIRE, "agent");
      xb_add(&bar[XB_XGEN(b.x)], 1u);
      asm volatile("s_waitcnt vmcnt(0)" ::: "memory");
    } else {
      XB_SPIN(xb_ld(&bar[XB_XGEN(b.x)]) == gen, bar);
      __builtin_amdgcn_fence(__ATOMIC_ACQUIRE, "agent");
      asm volatile("s_waitcnt vmcnt(0)" ::: "memory");
    }
  }
  __syncthreads();
}

__global__ void __launch_bounds__(256, 2) fwd_megakernel(Params p) {
  extern __shared__ __attribute__((aligned(16))) char lds[];
  cg::grid_group grid = cg::this_grid();
  const int nb = gridDim.x, bid = blockIdx.x;
  if (p.ws == nullptr) grid.sync();
  volatile LAS unsigned* bst = (volatile LAS unsigned*)(lds + LDS_BARST);
  if (threadIdx.x == 0) { bst[0] = 0u; bst[1] = 0u; }
  __syncthreads();
  const XcdBarrier xb = xcd_barrier_post((unsigned*)(p.ws + OFF_BAR), bst);

  phase0(p, lds);
  xcd_barrier(xb);

  for (int t = bid; t < 32 * 47; t += nb) p1_tile(p, t & 31, t >> 5, lds);
  xcd_barrier(xb);

  for (int t = bid; t < 32 * 12 + 32 * 16; t += nb) {
    if (t < 32 * 12) p2_q_tile(p, t & 31, t >> 5, lds);
    else { const int u = t - 32 * 12; p2_kv_tile(p, u & 31, u >> 5, lds); }
  }
  xcd_barrier(xb);

  for (int it = 511 - bid; it >= 0; it -= nb) {
    const int half = it >> 8, j = (it & 255) >> 3, head = it & 7, pr = it & 255;
    if (half == 0) mla_item(p, head, 63 - j, 0, 65, 2, pr, lds);
    else {
#pragma unroll 1
      for (int seg = 0; seg < 2; ++seg) mla_item(p, head, seg ? j : 63 - j, seg ? 0 : 65, seg ? 2 * j + 2 : 128 - 2 * j, seg ? 0 : 1, pr, lds);
    }
  }
  {
    unsigned* ctr = (unsigned*)(p.ws + OFF_CTR);
    volatile int* itemw = (volatile int*)(lds + LDS_MISC);
    for (;;) {
      __syncthreads();
      if (threadIdx.x == 0) *itemw = (int)atomicAdd(ctr, 1u);
      __syncthreads();
      const int it = *itemw;
      if (it >= 512) break;
      sb_item(p, it & 7, 63 - (it >> 3), lds);
    }
  }
  xcd_barrier(xb);

  for (int t = bid; t < 32 * 16; t += nb) p4_tile(p, t & 31, t >> 5, lds);
  xcd_barrier(xb);

  phase5(p);
}

extern "C" void kernel_launch(void* const* d_in, const int* in_sizes, int n_in, void* d_out, int out_size, void* d_ws, size_t ws_size, hipStream_t stream) {
  static int grid_blocks = 0;
  if (grid_blocks == 0) {
    if (n_in != 10 || in_sizes[0] != S * DM || out_size != S * DM || ws_size < WS_END) {
      fprintf(stderr, "kernel_launch: unexpected shapes n_in %d in0 %d out %d ws %zu (need %zu)\n", n_in, n_in > 0 ? in_sizes[0] : -1, out_size, ws_size, (size_t)WS_END);
      grid_blocks = -1; return;
    }
    int dev = 0, cus = 0, per_cu = 0;
    hipGetDevice(&dev);
    hipDeviceGetAttribute(&cus, hipDeviceAttributeMultiprocessorCount, dev);
    hipFuncSetAttribute((const void*)fwd_megakernel, hipFuncAttributeMaxDynamicSharedMemorySize, LDS_BYTES);
    hipOccupancyMaxActiveBlocksPerMultiprocessor(&per_cu, (const void*)fwd_megakernel, 256, LDS_BYTES);
    if (per_cu < 1) per_cu = 1;
    if (per_cu > 2) per_cu = 2;
    grid_blocks = cus * per_cu;
  }
  if (grid_blocks < 0) return;
  Params p{};
  p.x = (const float*)d_in[0]; p.pos = (const int*)d_in[1]; p.pre_w = (const float*)d_in[2]; p.w_in = (const float*)d_in[3];
  p.qn_w = (const float*)d_in[4]; p.w_qup = (const float*)d_in[5]; p.kvn_w = (const float*)d_in[6]; p.w_kvup = (const float*)d_in[7];
  p.w_out = (const float*)d_in[8]; p.post_w = (const float*)d_in[9]; p.out = (float*)d_out; p.ws = (unsigned char*)d_ws;
  if (hipMemsetAsync((char*)d_ws + OFF_BAR, 0, XCD_BAR_WORDS * 4, stream) != hipSuccess) { fprintf(stderr, "kernel_launch: memset of barrier words failed\n"); return; }
  void* args[] = {&p};
  hipError_t e = hipLaunchCooperativeKernel((const void*)fwd_megakernel, dim3(grid_blocks), dim3(256), args, LDS_BYTES, stream);
  if (e != hipSuccess) fprintf(stderr, "cooperative launch failed: %s (grid %d)\n", hipGetErrorString(e), grid_blocks);
}
```

```cpp
#include <hip/hip_runtime.h>
#include <hip/hip_cooperative_groups.h>
#include <cstdio>
namespace cg = cooperative_groups;

#define DI __device__ __forceinline__
typedef unsigned short u16;
using bf16x8 = __attribute__((ext_vector_type(8))) short;
using f32x16 = __attribute__((ext_vector_type(16))) float;
using f32x4  = __attribute__((ext_vector_type(4))) float;
using f32x2  = __attribute__((ext_vector_type(2))) float;
using u32x4  = __attribute__((ext_vector_type(4))) unsigned;
using u32x2  = __attribute__((ext_vector_type(2))) unsigned;
typedef __bf16 bf16x2_t __attribute__((ext_vector_type(2)));

constexpr int S = 8192, DM = 2048, DIN = 5952, DINP = 6016;
constexpr float EPS = 1e-6f;

constexpr size_t OFF_XB    = 0;
constexpr size_t OFF_WINT  = OFF_XB   + (size_t)S * DM * 2;
constexpr size_t OFF_WQT   = OFF_WINT + (size_t)DINP * DM * 2;
constexpr size_t OFF_WKVT  = OFF_WQT  + (size_t)1536 * 512 * 2;
constexpr size_t OFF_WOT   = OFF_WKVT + (size_t)2048 * 256 * 2;
constexpr size_t OFF_RSTDX = OFF_WOT  + (size_t)2048 * 2048 * 2;
constexpr size_t OFF_COS   = OFF_RSTDX + (size_t)S * 4;
constexpr size_t OFF_SIN   = OFF_COS  + (size_t)S * 32 * 4;
constexpr size_t OFF_SBQ   = OFF_SIN  + (size_t)S * 32 * 4;
constexpr size_t OFF_SBK   = OFF_SBQ  + (size_t)S * 1024 * 2;
constexpr size_t OFF_SBVT  = OFF_SBK  + (size_t)S * 1024 * 2;
constexpr size_t OFF_GATE  = OFF_SBVT + (size_t)S * 1024 * 2;
constexpr size_t OFF_CQ    = OFF_GATE + (size_t)S * 2048 * 2;
constexpr size_t OFF_CKV   = OFF_CQ   + (size_t)S * 512 * 2;
constexpr size_t OFF_KROT  = OFF_CKV  + (size_t)S * 256 * 2;
constexpr size_t OFF_CQSS  = OFF_KROT + (size_t)S * 64 * 2;
constexpr size_t OFF_CKVSS = OFF_CQSS + (size_t)S * 8 * 4;
constexpr size_t OFF_QMLA  = OFF_CKVSS + (size_t)S * 4 * 4;
constexpr size_t OFF_KNOPE = OFF_QMLA + (size_t)S * 1536 * 2;
constexpr size_t OFF_MVT   = OFF_KNOPE + (size_t)S * 1024 * 2;
constexpr size_t OFF_YSS   = OFF_MVT  + (size_t)S * 1024 * 2;
constexpr size_t OFF_CTR   = OFF_YSS  + (size_t)S * 32 * 4;
constexpr size_t OFF_BAR   = OFF_CTR + 2048;
constexpr size_t WS_END    = OFF_BAR + 16384;
constexpr size_t OFF_MIXED = OFF_XB;
constexpr size_t OFF_PART  = OFF_WINT;
constexpr size_t PART_STRIDE = 65536 + 2048;
static_assert(256 * PART_STRIDE <= (size_t)DINP * DM * 2, "partials must fit in the dead w_in^T region");
constexpr size_t OFF_FLAG  = OFF_CTR + 64;
constexpr size_t OFF_Y     = OFF_SBQ;

constexpr int LDS_BYTES = 73728 + 256;
constexpr int LDS_BARST = 73728;

struct Params {
  const float* x; const int* pos; const float* pre_w; const float* w_in; const float* qn_w; const float* w_qup;
  const float* kvn_w; const float* w_kvup; const float* w_out; const float* post_w; float* out; unsigned char* ws;
};

DI unsigned pack2(float lo, float hi) { f32x2 v = {lo, hi}; bf16x2_t r = __builtin_convertvector(v, bf16x2_t); return __builtin_bit_cast(unsigned, r); }
DI float bflo(unsigned w) { return __uint_as_float(w << 16); }
DI float bfhi(unsigned w) { return __uint_as_float(w & 0xffff0000u); }
DI void store4bf(u16* dst, float a, float b, float c, float d) { u32x2 v = {pack2(a, b), pack2(c, d)}; *(u32x2*)dst = v; }
DI float xhalf_sum(float v) { auto rr = __builtin_amdgcn_permlane32_swap(__float_as_uint(v), __float_as_uint(v), false, false); return __uint_as_float(rr[0]) + __uint_as_float(rr[1]); }
DI float xhalf_max(float v) { auto rr = __builtin_amdgcn_permlane32_swap(__float_as_uint(v), __float_as_uint(v), false, false); return fmaxf(__uint_as_float(rr[0]), __uint_as_float(rr[1])); }
DI float xhalf_other(float v, int h) { auto rr = __builtin_amdgcn_permlane32_swap(__float_as_uint(v), __float_as_uint(v), false, false); return __uint_as_float(h ? rr[0] : rr[1]); }
DI float wave_sum(float v, int lane) {
#pragma unroll
  for (int o = 32; o > 0; o >>= 1) v += __int_as_float(__builtin_amdgcn_ds_bpermute((lane ^ o) << 2, __float_as_int(v)));
  return v;
}
DI int fresh_tid() { int t = threadIdx.x; asm volatile("" : "+v"(t)); return t; }
DI float silu(float v) { return v * __builtin_amdgcn_rcpf(1.f + __builtin_amdgcn_exp2f(-1.4426950408889634f * v)); }
DI void dma16(const void* gsrc, char* lds_wave_base) { __builtin_amdgcn_global_load_lds((const unsigned*)gsrc, (unsigned*)lds_wave_base, 16, 0, 0); }

template <int OFF> DI void ds_rd128(bf16x8& dst, unsigned addr) { asm volatile("ds_read_b128 %0, %1 offset:%2" : "=v"(dst) : "v"(addr), "i"(OFF)); }
template <int OFF> DI void ds_rd64(u32x2& dst, unsigned addr)  { asm volatile("ds_read_b64 %0, %1 offset:%2" : "=v"(dst) : "v"(addr), "i"(OFF)); }
template <int N> DI void lgkm_wait1(bf16x8& a) { asm volatile("s_waitcnt lgkmcnt(%1)" : "+v"(a) : "i"(N)); }
template <int N> DI void lgkm_wait2(bf16x8& a, bf16x8& b) { asm volatile("s_waitcnt lgkmcnt(%2)" : "+v"(a), "+v"(b) : "i"(N)); }
template <int N> DI void lgkm_wait2(u32x2& a, u32x2& b)   { asm volatile("s_waitcnt lgkmcnt(%2)" : "+v"(a), "+v"(b) : "i"(N)); }

DI u32x4 widen16(u32x2 a, u32x2 b) {
  auto r0 = __builtin_amdgcn_permlane32_swap(a[0], b[0], false, false);
  auto r1 = __builtin_amdgcn_permlane32_swap(a[1], b[1], false, false);
  u32x4 w = {r0[0], r1[0], r0[1], r1[1]};
  return w;
}
#define MFMA(a, b, c) __builtin_amdgcn_mfma_f32_32x32x16_bf16((a), (b), (c), 0, 0, 0)

constexpr int GM = 256, GN = 128, G_STAGE_B = 24576;
DI size_t kblk(int rows, int row, int k) { return ((size_t)(k >> 5) * rows + row) * 32 + (k & 31); }
template <bool SWAP>
DI void gemm_mainloop(f32x16 (&acc)[4][2], const u16* __restrict__ A, int lda, const u16* __restrict__ Bt, int ldb, int K, int m0, int n0, char* lds) {
  const int tid = fresh_tid(), wid = __builtin_amdgcn_readfirstlane(tid >> 6), lane = tid & 63, r32 = lane & 31, h = lane >> 5, wr = wid >> 1, wc = wid & 1;
#pragma unroll
  for (int a = 0; a < 4; ++a)
#pragma unroll
    for (int b = 0; b < 2; ++b)
#pragma unroll
      for (int r = 0; r < 16; ++r) acc[a][b][r] = 0.f;
  const int srow = wid * 16 + (lane >> 2);
  const int schunk = (lane & 3) ^ ((lane >> 4) & 3);
  const char* Ab = (const char*)(A + (size_t)m0 * 32);
  const char* Bb = (const char*)(Bt + (size_t)n0 * 32);
  const unsigned aoff = (unsigned)((srow * 32 + schunk * 8) * 2), boff = aoff;
  const size_t astage = (size_t)lda * 64, bstage = (size_t)ldb * 64;
  char* wbase = lds + wid * 1024 + lane * 16;
  u32x4 ra[4], rb[2];
#define G_LOAD(s_) do { const char* a_ = Ab + (size_t)(s_) * astage + aoff; const char* b_ = Bb + (size_t)(s_) * bstage + boff; \
    _Pragma("unroll") for (int i = 0; i < 4; ++i) ra[i] = *(const u32x4*)(a_ + i * 4096); \
    _Pragma("unroll") for (int i = 0; i < 2; ++i) rb[i] = *(const u32x4*)(b_ + i * 4096); } while (0)
#define G_WRITE(bufoff) do { \
    _Pragma("unroll") for (int i = 0; i < 4; ++i) *(u32x4*)(wbase + (bufoff) + i * 4096) = ra[i]; \
    _Pragma("unroll") for (int i = 0; i < 2; ++i) *(u32x4*)(wbase + (bufoff) + 16384 + i * 4096) = rb[i]; } while (0)
  const int nk = K >> 5;
  __syncthreads();
  G_LOAD(0); G_WRITE(0); G_LOAD(1);
  __syncthreads();
  const int swz = (r32 >> 2) & 3;
  const int arow = (wr * 128 + r32) * 64, brow = 16384 + (wc * 64 + r32) * 64;
  bf16x8 af[2][4], bfr[2][2];
#define F_READ(set, St_) do { const int co_ = ((2 * (set) + h) ^ swz) << 4; \
    _Pragma("unroll") for (int t = 0; t < 4; ++t) af[set][t] = *(const bf16x8*)((St_) + arow + t * 2048 + co_); \
    _Pragma("unroll") for (int t = 0; t < 2; ++t) bfr[set][t] = *(const bf16x8*)((St_) + brow + t * 2048 + co_); } while (0)
#define F_MMA(set) do { _Pragma("unroll") for (int mt = 0; mt < 4; ++mt) _Pragma("unroll") for (int nt = 0; nt < 2; ++nt) \
    acc[mt][nt] = SWAP ? MFMA(af[set][mt], bfr[set][nt], acc[mt][nt]) : MFMA(bfr[set][nt], af[set][mt], acc[mt][nt]); } while (0)
#pragma unroll 1
  for (int s_ = 0; s_ < nk; ++s_) {
    const int cur = (s_ & 1) * G_STAGE_B, nxt = G_STAGE_B - cur;
    const char* St = lds + cur;
    F_READ(0, St);
    __builtin_amdgcn_sched_barrier(0);
    if (s_ > 0) F_MMA(1);
    __builtin_amdgcn_sched_barrier(0);
    F_READ(1, St);
    if (s_ + 1 < nk) G_WRITE(nxt);
    if (s_ + 2 < nk) G_LOAD(s_ + 2);
    __builtin_amdgcn_sched_barrier(0);
    F_MMA(0);
    __builtin_amdgcn_sched_barrier(0);
    __syncthreads();
  }
  F_MMA(1);
#undef F_READ
#undef F_MMA
#undef G_LOAD
#undef G_WRITE
}

template <bool SILU, bool KB = false>
DI void store_strip(const f32x16 (&acc)[4][2], u16* base, int ld, int col0, int tok0, const float (&rs)[4], int r32, int h) {
#pragma unroll
  for (int mt = 0; mt < 4; ++mt) {
    u16* rowp = KB ? base + kblk(S, tok0 + mt * 32 + r32, col0) + 8 * h : base + (size_t)(tok0 + mt * 32 + r32) * ld + col0 + 8 * h;
    const size_t ntstep = KB ? (size_t)S * 32 : 32;
#pragma unroll
    for (int nt = 0; nt < 2; ++nt)
#pragma unroll
      for (int k = 0; k < 2; ++k) {
        u32x2 pk[2];
#pragma unroll
        for (int e = 0; e < 2; ++e) {
          const int g = 2 * k + e;
          float v0 = acc[mt][nt][4 * g] * rs[mt], v1 = acc[mt][nt][4 * g + 1] * rs[mt], v2 = acc[mt][nt][4 * g + 2] * rs[mt], v3 = acc[mt][nt][4 * g + 3] * rs[mt];
          if (SILU) { v0 = silu(v0); v1 = silu(v1); v2 = silu(v2); v3 = silu(v3); }
          pk[e][0] = pack2(v0, v1); pk[e][1] = pack2(v2, v3);
        }
        *(u32x4*)(rowp + nt * ntstep + 16 * k) = widen16(pk[0], pk[1]);
      }
    __builtin_amdgcn_sched_barrier(0);
  }
}
template <bool SILU>
DI void store_strip_rows(const f32x16 (&acc)[4][2], u16* base, int ld, int col0, int tok0, const float (&rs)[4], int r32, int h, char* lds, int wid, int lane) {
  char* wl = lds + wid * 16384;
#pragma unroll
  for (int mt = 0; mt < 4; ++mt) {
    const int row = mt * 32 + r32;
#pragma unroll
    for (int nt = 0; nt < 2; ++nt)
#pragma unroll
      for (int k = 0; k < 2; ++k) {
        u32x2 pk[2];
#pragma unroll
        for (int e = 0; e < 2; ++e) {
          const int g = 2 * k + e;
          float v0 = acc[mt][nt][4 * g] * rs[mt], v1 = acc[mt][nt][4 * g + 1] * rs[mt], v2 = acc[mt][nt][4 * g + 2] * rs[mt], v3 = acc[mt][nt][4 * g + 3] * rs[mt];
          if (SILU) { v0 = silu(v0); v1 = silu(v1); v2 = silu(v2); v3 = silu(v3); }
          pk[e][0] = pack2(v0, v1); pk[e][1] = pack2(v2, v3);
        }
        const int c = nt * 4 + 2 * k + h;
        *(u32x4*)(wl + row * 128 + ((c ^ (row & 7)) << 4)) = widen16(pk[0], pk[1]);
      }
    __builtin_amdgcn_sched_barrier(0);
  }
  const int rr = lane >> 3, c = lane & 7;
  u16* gp = base + (size_t)(tok0 + rr) * ld + col0 + c * 8;
#pragma unroll
  for (int i = 0; i < 16; ++i) {
    const int row = i * 8 + rr;
    const u32x4 v = *(const u32x4*)(wl + row * 128 + ((c ^ (row & 7)) << 4));
    *(u32x4*)(gp + (size_t)(i * 8) * ld) = v;
  }
}
DI void store_rope_strip(const f32x16 (&acc)[4][2], u16* base, int ld, int col0, int tok0, const float (&rs)[4], int r32, int h, const float* COS, const float* SIN) {
#pragma unroll
  for (int mt = 0; mt < 4; ++mt) {
    const int tok = tok0 + mt * 32 + r32;
    u16* rowp = base + (size_t)tok * ld + col0 + 4 * h;
#pragma unroll
    for (int g = 0; g < 4; ++g) {
      const f32x4 c = *(const f32x4*)(COS + (size_t)tok * 32 + 8 * g + 4 * h);
      const f32x4 s = *(const f32x4*)(SIN + (size_t)tok * 32 + 8 * g + 4 * h);
      float o1[4], o2[4];
#pragma unroll
      for (int i = 0; i < 4; ++i) {
        const float x1 = acc[mt][0][4 * g + i] * rs[mt], x2 = acc[mt][1][4 * g + i] * rs[mt];
        o1[i] = x1 * c[i] - x2 * s[i]; o2[i] = x2 * c[i] + x1 * s[i];
      }
      store4bf(rowp + 8 * g, o1[0], o1[1], o1[2], o1[3]);
      store4bf(rowp + 32 + 8 * g, o2[0], o2[1], o2[2], o2[3]);
      __builtin_amdgcn_sched_barrier(0);
    }
  }
}
DI void strip_sumsq(const f32x16 (&acc)[4][2], float* ss, int nslot, int slot, int tok0, const float (&rs)[4], int r32, int h) {
#pragma unroll
  for (int mt = 0; mt < 4; ++mt) {
    float s = 0.f;
#pragma unroll
    for (int nt = 0; nt < 2; ++nt)
#pragma unroll
      for (int r = 0; r < 16; ++r) { const float v = acc[mt][nt][r] * rs[mt]; s += v * v; }
    s = xhalf_sum(s);
    if (h == 0) ss[(size_t)(tok0 + mt * 32 + r32) * nslot + slot] = s;
  }
}
template <bool KVSS>
DI void store_strip_T(const f32x16 (&acc)[4][2], u16* baseT, int feat0, int tok0, const float* rsrc, int r32, int h) {
#pragma unroll
  for (int mt = 0; mt < 4; ++mt)
#pragma unroll
    for (int k = 0; k < 2; ++k) {
      f32x4 r4[2];
#pragma unroll
      for (int e = 0; e < 2; ++e) {
        const int tb = tok0 + mt * 32 + 8 * (2 * k + e) + 4 * h;
        if (KVSS) {
#pragma unroll
          for (int i = 0; i < 4; ++i) { const f32x4 a = *(const f32x4*)(rsrc + (size_t)(tb + i) * 4); r4[e][i] = rsqrtf(((a[0] + a[1]) + (a[2] + a[3])) * (1.f / 256.f) + EPS); }
        } else r4[e] = *(const f32x4*)(rsrc + tb);
      }
#pragma unroll
      for (int nt = 0; nt < 2; ++nt) {
        u32x2 pk[2];
#pragma unroll
        for (int e = 0; e < 2; ++e) {
          const int g = 2 * k + e;
          pk[e][0] = pack2(acc[mt][nt][4 * g] * r4[e][0], acc[mt][nt][4 * g + 1] * r4[e][1]);
          pk[e][1] = pack2(acc[mt][nt][4 * g + 2] * r4[e][2], acc[mt][nt][4 * g + 3] * r4[e][3]);
        }
        const u32x4 w_ = {pk[0][0], pk[0][1], pk[1][0], pk[1][1]};
        *(u32x4*)(baseT + (size_t)(feat0 + nt * 32 + r32) * S + tok0 + mt * 32 + 16 * k + 8 * h) = w_;
      }
    }
}

DI void p1_tile(const Params& p, int tm, int tn, char* lds) {
  unsigned char* ws = p.ws;
  const int wid = __builtin_amdgcn_readfirstlane(fresh_tid() >> 6), wr = wid >> 1, wc = wid & 1;
  const int m0 = tm * GM, n0 = tn * GN;
  const u16* A = (const u16*)(ws + OFF_XB); const u16* Bt = (const u16*)(ws + OFF_WINT);
  const float* rstdx = (const float*)(ws + OFF_RSTDX);
  const int tok0 = m0 + wr * 128;
  f32x16 acc[4][2];
  if (n0 >= 2048 && n0 < 3072) {
    gemm_mainloop<true>(acc, A, S, Bt, DINP, DM, m0, n0, lds);
    const int lane = fresh_tid() & 63, r32 = lane & 31, h = lane >> 5;
    store_strip_T<false>(acc, (u16*)(ws + OFF_SBVT), n0 - 2048 + wc * 64, tok0, rstdx, r32, h);
    return;
  }
  gemm_mainloop<false>(acc, A, S, Bt, DINP, DM, m0, n0, lds);
  const int lane = fresh_tid() & 63, r32 = lane & 31, h = lane >> 5;
  float rs[4];
#pragma unroll
  for (int mt = 0; mt < 4; ++mt) rs[mt] = rstdx[tok0 + mt * 32 + r32];
  const int fb = n0 + wc * 64;
  if (fb < 1024)      store_strip_rows<false>(acc, (u16*)(ws + OFF_SBQ), 1024, fb, tok0, rs, r32, h, lds, wid, lane);
  else if (fb < 2048) store_strip_rows<false>(acc, (u16*)(ws + OFF_SBK), 1024, fb - 1024, tok0, rs, r32, h, lds, wid, lane);
  else if (fb < 4096) store_strip_rows<true>(acc, (u16*)(ws + OFF_GATE), 2048, fb - 3072, tok0, rs, r32, h, lds, wid, lane);
  else if (fb < 4608) { store_strip<false, true>(acc, (u16*)(ws + OFF_CQ), 512, fb - 4096, tok0, rs, r32, h); strip_sumsq(acc, (float*)(ws + OFF_CQSS), 8, (fb - 4096) >> 6, tok0, rs, r32, h); }
  else if (fb < 4864) { store_strip<false, true>(acc, (u16*)(ws + OFF_CKV), 256, fb - 4608, tok0, rs, r32, h); strip_sumsq(acc, (float*)(ws + OFF_CKVSS), 4, (fb - 4608) >> 6, tok0, rs, r32, h); }
  else if (fb < 4928) store_rope_strip(acc, (u16*)(ws + OFF_KROT), 64, 0, tok0, rs, r32, h, (const float*)(ws + OFF_COS), (const float*)(ws + OFF_SIN));
  else if (fb < DIN)  store_strip_rows<true>(acc, (u16*)(ws + OFF_GATE), 2048, 1024 + fb - 4928, tok0, rs, r32, h, lds, wid, lane);
}

DI void p2_q_tile(const Params& p, int tm, int tn, char* lds) {
  unsigned char* ws = p.ws;
  const int wid = __builtin_amdgcn_readfirstlane(fresh_tid() >> 6), wr = wid >> 1, wc = wid & 1;
  const int m0 = tm * GM, n0 = tn * GN, tok0 = m0 + wr * 128;
  f32x16 acc[4][2];
  gemm_mainloop<false>(acc, (const u16*)(ws + OFF_CQ), S, (const u16*)(ws + OFF_WQT), 1536, 512, m0, n0, lds);
  const int lane = fresh_tid() & 63, r32 = lane & 31, h = lane >> 5;
  const float* ssq = (const float*)(ws + OFF_CQSS);
  float rs[4];
#pragma unroll
  for (int mt = 0; mt < 4; ++mt) {
    const f32x4 a = *(const f32x4*)(ssq + (size_t)(tok0 + mt * 32 + r32) * 8), b = *(const f32x4*)(ssq + (size_t)(tok0 + mt * 32 + r32) * 8 + 4);
    rs[mt] = rsqrtf(((a[0] + a[1]) + (a[2] + a[3]) + (b[0] + b[1]) + (b[2] + b[3])) * (1.f / 512.f) + EPS);
  }
  const int fb = n0 + wc * 64;
  if ((fb % 192) == 128) store_rope_strip(acc, (u16*)(ws + OFF_QMLA), 1536, fb, tok0, rs, r32, h, (const float*)(ws + OFF_COS), (const float*)(ws + OFF_SIN));
  else                   store_strip_rows<false>(acc, (u16*)(ws + OFF_QMLA), 1536, fb, tok0, rs, r32, h, lds, wid, lane);
}
DI float kv_rstd(const float* sskv, int tok) { const f32x4 a = *(const f32x4*)(sskv + (size_t)tok * 4); return rsqrtf(((a[0] + a[1]) + (a[2] + a[3])) * (1.f / 256.f) + EPS); }
DI void p2_kv_tile(const Params& p, int tm, int tn, char* lds) {
  unsigned char* ws = p.ws;
  const int wid = __builtin_amdgcn_readfirstlane(fresh_tid() >> 6), wr = wid >> 1, wc = wid & 1;
  const int m0 = tm * GM, n0 = tn * GN, tok0 = m0 + wr * 128, hd = n0 >> 8;
  const float* sskv = (const float*)(ws + OFF_CKVSS);
  f32x16 acc[4][2];
  if (n0 & 128) {
    gemm_mainloop<true>(acc, (const u16*)(ws + OFF_CKV), S, (const u16*)(ws + OFF_WKVT), 2048, 256, m0, n0, lds);
    const int lane = fresh_tid() & 63, r32 = lane & 31, h = lane >> 5;
    store_strip_T<true>(acc, (u16*)(ws + OFF_MVT), hd * 128 + wc * 64, tok0, sskv, r32, h);
  } else {
    gemm_mainloop<false>(acc, (const u16*)(ws + OFF_CKV), S, (const u16*)(ws + OFF_WKVT), 2048, 256, m0, n0, lds);
    const int lane = fresh_tid() & 63, r32 = lane & 31, h = lane >> 5;
    float rs[4];
#pragma unroll
    for (int mt = 0; mt < 4; ++mt) rs[mt] = kv_rstd(sskv, tok0 + mt * 32 + r32);
    store_strip_rows<false>(acc, (u16*)(ws + OFF_KNOPE), 1024, hd * 128 + wc * 64, tok0, rs, r32, h, lds, wid, lane);
  }
}

DI void p4_tile(const Params& p, int tm, int tn, char* lds) {
  unsigned char* ws = p.ws;
  const int wid = __builtin_amdgcn_readfirstlane(fresh_tid() >> 6), wr = wid >> 1, wc = wid & 1;
  const int m0 = tm * GM, n0 = tn * GN, tok0 = m0 + wr * 128;
  f32x16 acc[4][2];
  gemm_mainloop<false>(acc, (const u16*)(ws + OFF_MIXED), S, (const u16*)(ws + OFF_WOT), 2048, 2048, m0, n0, lds);
  const int lane = fresh_tid() & 63, r32 = lane & 31, h = lane >> 5;
  const int fb = n0 + wc * 64;
  const float one[4] = {1.f, 1.f, 1.f, 1.f};
  store_strip_rows<false>(acc, (u16*)(ws + OFF_Y), 2048, fb, tok0, one, r32, h, lds, wid, lane);
  strip_sumsq(acc, (float*)(ws + OFF_YSS), 32, fb >> 6, tok0, one, r32, h);
}

constexpr int SB_VT = 24576, LDS_MISC = 40960;
constexpr int MLA_KN = 0, MLA_KR = 32768, MLA_VT = 49152;

DI void vt_load(u32x4 (&vreg)[4], const u16* VT, int head, int key0, int tid) {
  const char* base = (const char*)(VT + (size_t)(head * 128) * S + key0);
  const unsigned voff = (unsigned)(((tid >> 3) * S + (tid & 7) * 8) * 2);
#pragma unroll
  for (int i = 0; i < 4; ++i) vreg[i] = *(const u32x4*)(base + (size_t)(32 * i) * S * 2 + voff);
}
template <int LDS_VT>
DI void vt_write(const u32x4 (&vreg)[4], char* lds, int tid) {
  const int d = tid >> 3, c = tid & 7, sw = (d >> 1) & 7;
  char* b0 = lds + LDS_VT + d * 128 + ((c ^ sw) << 4);
#pragma unroll
  for (int i = 0; i < 4; ++i) *(u32x4*)(b0 + i * 4096) = vreg[i];
}
template <int LDS_VT>
DI void pv_tile(f32x16 (&o)[4], const bf16x8 (&pf)[2][2], const char* lds, int r32, int h) {
  const int sw = (r32 >> 1) & 7;
  const unsigned base = (unsigned)(size_t)(lds + LDS_VT + r32 * 128);
  unsigned adr[4];
#pragma unroll
  for (int k = 0; k < 4; ++k) adr[k] = base + (((2 * k + h) ^ sw) << 4);
  bf16x8 vf[4];
#define PV_READ(q) do { switch ((q) >> 2) { \
    case 0: ds_rd128<0>(vf[(q) & 3], adr[(q) & 3]); break; \
    case 1: ds_rd128<4096>(vf[(q) & 3], adr[(q) & 3]); break; \
    case 2: ds_rd128<8192>(vf[(q) & 3], adr[(q) & 3]); break; \
    default: ds_rd128<12288>(vf[(q) & 3], adr[(q) & 3]); break; } } while (0)
  PV_READ(0); PV_READ(1); PV_READ(2);
#pragma unroll
  for (int q = 0; q < 16; ++q) {
    if (q + 3 < 16) PV_READ(q + 3);
    if (q + 3 < 16) lgkm_wait1<3>(vf[q & 3]); else if (q + 2 < 16) lgkm_wait1<2>(vf[q & 3]); else if (q + 1 < 16) lgkm_wait1<1>(vf[q & 3]); else lgkm_wait1<0>(vf[q & 3]);
    o[q >> 2] = MFMA(vf[q & 3], pf[(q >> 1) & 1][q & 1], o[q >> 2]);
  }
#undef PV_READ
}
DI bf16x8 pack8(const f32x16& x, int s2) {
  const u32x4 w = {pack2(x[8 * s2], x[8 * s2 + 1]), pack2(x[8 * s2 + 2], x[8 * s2 + 3]), pack2(x[8 * s2 + 4], x[8 * s2 + 5]), pack2(x[8 * s2 + 6], x[8 * s2 + 7])};
  return __builtin_bit_cast(bf16x8, w);
}
DI void attn_store(const f32x16 (&o)[4], float scale, const u16* gate, u16* mixed, int tok, int col0, int h) {
  const u16* gp = gate + (size_t)tok * 2048 + col0 + 4 * h;
  u16* op = mixed + kblk(S, tok, col0) + 8 * h;
#pragma unroll
  for (int dt = 0; dt < 4; ++dt)
#pragma unroll
    for (int k = 0; k < 2; ++k) {
      u32x2 pk[2];
#pragma unroll
      for (int e = 0; e < 2; ++e) {
        const int g = 2 * k + e;
        const u32x2 gw = *(const u32x2*)(gp + dt * 32 + 8 * g);
        pk[e][0] = pack2(o[dt][4 * g] * scale * bflo(gw[0]), o[dt][4 * g + 1] * scale * bfhi(gw[0]));
        pk[e][1] = pack2(o[dt][4 * g + 2] * scale * bflo(gw[1]), o[dt][4 * g + 3] * scale * bfhi(gw[1]));
      }
      *(u32x4*)(op + (size_t)dt * S * 32 + 16 * k) = widen16(pk[0], pk[1]);
    }
}

DI void mla_item(const Params& p, int head, int qb, int t0, int t1, int mode, int pr, char* lds) {
  unsigned char* ws = p.ws;
  const int tid = fresh_tid(), wid = __builtin_amdgcn_readfirstlane(tid >> 6), lane = tid & 63, r32 = lane & 31, h = lane >> 5;
  const u16* Q = (const u16*)(ws + OFF_QMLA); const u16* KN = (const u16*)(ws + OFF_KNOPE); const u16* KR = (const u16*)(ws + OFF_KROT); const u16* VT = (const u16*)(ws + OFF_MVT);
  const int tok = qb * 128 + wid * 32 + r32;
  bf16x8 qf[12];
#pragma unroll
  for (int ks = 0; ks < 12; ++ks) qf[ks] = *(const bf16x8*)(Q + (size_t)tok * 1536 + head * 192 + ks * 16 + h * 8);
  f32x16 o[4];
#pragma unroll
  for (int dt = 0; dt < 4; ++dt)
#pragma unroll
    for (int r = 0; r < 16; ++r) o[dt][r] = 0.f;
  float m = -1e30f, l = 0.f;
  const int mynt = 2 * qb + 1 + (wid >> 1);
  constexpr float C = 0.07216878364870323f * 1.4426950408889634f;
  constexpr float MLA_THR = 8.f * 1.4426950408889634f;
  u32x4 vreg[4];
  const int knr = wid * 4 + (lane >> 4), krr = wid * 8 + (lane >> 3);
  const unsigned kn_off = (unsigned)((knr * 1024 + (((lane & 15) ^ (knr & 15)) * 8)) * 2);
  const unsigned kr_off = (unsigned)((krr * 64 + (((lane & 7) ^ ((krr >> 1) & 7)) * 8)) * 2);
  const unsigned v_off = (unsigned)(((tid >> 3) * S + (tid & 7) * 8) * 2);
#define STAGE_PIECE(i, tn) do { \
    if ((i) < 4) dma16((const char*)(KN + (size_t)(tn) * 64 * 1024 + head * 128) + kn_off + (i) * 32768, lds + MLA_KN + ((tn) & 1) * 16384 + wid * 1024 + (i) * 4096); \
    else if ((i) < 6) dma16((const char*)(KR + (size_t)(tn) * 64 * 64) + kr_off + ((i) - 4) * 4096, lds + MLA_KR + ((tn) & 1) * 8192 + wid * 1024 + ((i) - 4) * 4096); \
    else vreg[(i) - 6] = *(const u32x4*)((const char*)(VT + (size_t)(head * 128) * S + (size_t)(tn) * 64) + (size_t)(32 * ((i) - 6)) * S * 2 + v_off); } while (0)
  __syncthreads();
#pragma unroll
  for (int i = 0; i < 10; ++i) STAGE_PIECE(i, t0);
  const int sw16 = r32 & 15, sw8 = (r32 >> 1) & 7;
  const int swv = (r32 >> 1) & 7;
  const unsigned vbase = (unsigned)(size_t)(lds + MLA_VT + r32 * 128);
  unsigned adrv[4];
#pragma unroll
  for (int k = 0; k < 4; ++k) adrv[k] = vbase + (((2 * k + h) ^ swv) << 4);
  for (int t = t0; t < t1; ++t) {
    __syncthreads();
    vt_write<MLA_VT>(vreg, lds, tid);
    asm volatile("s_waitcnt vmcnt(0)" ::: "memory");
    __syncthreads();
    const bool more = t + 1 < t1;
    if (t < mynt) {
      const unsigned knu = (unsigned)(size_t)(lds + MLA_KN + (t & 1) * 16384 + r32 * 256);
      const unsigned kru = (unsigned)(size_t)(lds + MLA_KR + (t & 1) * 8192 + r32 * 128);
      f32x16 sa, sb;
#pragma unroll
      for (int r = 0; r < 16; ++r) { sa[r] = 0.f; sb[r] = 0.f; }
      bf16x8 kf[3];
      bf16x8 vf[4];
      bf16x8 pfa[2], pfb[2];
      float mx1 = 0.f, alpha = 1.f, negm = 0.f, ps = 0.f;
#define K_READ(j) do { const int ks_ = (j) % 12; \
        if (ks_ < 8) { const unsigned a_ = knu + (((2 * ks_ + h) ^ sw16) << 4); if ((j) >= 12) ds_rd128<8192>(kf[(j) % 3], a_); else ds_rd128<0>(kf[(j) % 3], a_); } \
        else { const unsigned a_ = kru + (((2 * (ks_ - 8) + h) ^ sw8) << 4); if ((j) >= 12) ds_rd128<4096>(kf[(j) % 3], a_); else ds_rd128<0>(kf[(j) % 3], a_); } } while (0)
#define V_READ(n) do { const int k_ = ((n) >> 3) * 2 + ((n) & 1); switch (((n) >> 1) & 3) { \
        case 0: ds_rd128<0>(vf[(n) & 3], adrv[k_]); break; \
        case 1: ds_rd128<4096>(vf[(n) & 3], adrv[k_]); break; \
        case 2: ds_rd128<8192>(vf[(n) & 3], adrv[k_]); break; \
        default: ds_rd128<12288>(vf[(n) & 3], adrv[k_]); break; } } while (0)
      K_READ(0); K_READ(1);
#pragma unroll
      for (int ks = 0; ks < 12; ++ks) {
        K_READ(ks + 2);
        lgkm_wait1<2>(kf[ks % 3]);
        sa = MFMA(kf[ks % 3], qf[ks], sa);
        if (more && ks < 10) STAGE_PIECE(ks, t + 1);
        __builtin_amdgcn_sched_barrier(0);
      }
#pragma unroll
      for (int ks = 0; ks < 12; ++ks) {
        if (ks < 10) K_READ(12 + ks + 2); else if (ks == 10) V_READ(0); else { V_READ(1); V_READ(2); }
        if (ks < 10) lgkm_wait1<2>(kf[ks % 3]); else if (ks == 10) lgkm_wait1<2>(kf[ks % 3]); else lgkm_wait1<3>(kf[ks % 3]);
        sb = MFMA(kf[ks % 3], qf[ks], sb);
        if (ks == 0) { mx1 = fmaxf(fmaxf(fmaxf(sa[0], sa[1]), fmaxf(sa[2], sa[3])), fmaxf(fmaxf(sa[4], sa[5]), fmaxf(sa[6], sa[7]))); }
        else if (ks == 1) { mx1 = fmaxf(mx1, fmaxf(fmaxf(fmaxf(sa[8], sa[9]), fmaxf(sa[10], sa[11])), fmaxf(fmaxf(sa[12], sa[13]), fmaxf(sa[14], sa[15])))); }
        else if (ks == 2) { const float mx = xhalf_max(mx1) * C;     if (__all(mx - m <= MLA_THR)) { alpha = 1.f; } else { const float mnew = fmaxf(m, mx); alpha = __builtin_amdgcn_exp2f(m - mnew); m = mnew; } negm = -m; }
        else if (ks == 3) { if (!__all(alpha == 1.f)) {
#pragma unroll
            for (int dt = 0; dt < 4; ++dt)
#pragma unroll
              for (int r = 0; r < 16; ++r) o[dt][r] *= alpha; } }
        else if (ks < 8) {
#pragma unroll
          for (int i = 0; i < 4; ++i) sa[4 * (ks - 4) + i] = __builtin_amdgcn_exp2f(fmaf(sa[4 * (ks - 4) + i], C, negm)); }
        else if (ks == 8) { ps = ((sa[0] + sa[1]) + (sa[2] + sa[3])) + ((sa[4] + sa[5]) + (sa[6] + sa[7])) + (((sa[8] + sa[9]) + (sa[10] + sa[11])) + ((sa[12] + sa[13]) + (sa[14] + sa[15]))); }
        else if (ks == 9) { l = l * alpha + ps; }
        else if (ks == 10) pfa[0] = pack8(sa, 0);
        else pfa[1] = pack8(sa, 1);
        __builtin_amdgcn_sched_barrier(0);
      }
#pragma unroll
      for (int q = 0; q < 8; ++q) {
        V_READ(q + 3);
        lgkm_wait1<3>(vf[q & 3]);
        o[q >> 1] = MFMA(vf[q & 3], pfa[q & 1], o[q >> 1]);
        if (q == 0) { mx1 = fmaxf(fmaxf(fmaxf(sb[0], sb[1]), fmaxf(sb[2], sb[3])), fmaxf(fmaxf(sb[4], sb[5]), fmaxf(sb[6], sb[7]))); }
        else if (q == 1) { mx1 = fmaxf(mx1, fmaxf(fmaxf(fmaxf(sb[8], sb[9]), fmaxf(sb[10], sb[11])), fmaxf(fmaxf(sb[12], sb[13]), fmaxf(sb[14], sb[15]))));
                           const float mx = xhalf_max(mx1) * C;     if (__all(mx - m <= MLA_THR)) { alpha = 1.f; } else { const float mnew = fmaxf(m, mx); alpha = __builtin_amdgcn_exp2f(m - mnew); m = mnew; } negm = -m; }
        else if (q < 6) {
#pragma unroll
          for (int i = 0; i < 4; ++i) sb[4 * (q - 2) + i] = __builtin_amdgcn_exp2f(fmaf(sb[4 * (q - 2) + i], C, negm)); }
        else if (q == 6) { ps = ((sb[0] + sb[1]) + (sb[2] + sb[3])) + ((sb[4] + sb[5]) + (sb[6] + sb[7])) + (((sb[8] + sb[9]) + (sb[10] + sb[11])) + ((sb[12] + sb[13]) + (sb[14] + sb[15]))); l = l * alpha + ps; }
        else { pfb[0] = pack8(sb, 0); pfb[1] = pack8(sb, 1); }
        __builtin_amdgcn_sched_barrier(0);
      }
      if (!__all(alpha == 1.f)) {
#pragma unroll
        for (int dt = 0; dt < 4; ++dt)
#pragma unroll
          for (int r = 0; r < 16; ++r) o[dt][r] *= alpha;
      }
      __builtin_amdgcn_sched_barrier(0);
#pragma unroll
      for (int q = 8; q < 16; ++q) {
        if (q + 3 < 16) V_READ(q + 3);
        if (q + 3 < 16) lgkm_wait1<3>(vf[q & 3]); else if (q + 2 < 16) lgkm_wait1<2>(vf[q & 3]); else if (q + 1 < 16) lgkm_wait1<1>(vf[q & 3]); else lgkm_wait1<0>(vf[q & 3]);
          o[(q >> 1) & 3] = MFMA(vf[q & 3], pfb[q & 1], o[(q >> 1) & 3]);
        __builtin_amdgcn_sched_barrier(0);
      }
#undef K_READ
#undef V_READ
    } else if (more) {
#pragma unroll
      for (int i = 0; i < 10; ++i) STAGE_PIECE(i, t + 1);
    }
  }
#undef STAGE_PIECE
  int tok2 = tok; asm volatile("" : "+v"(tok2));
  float* part = (float*)(ws + OFF_PART + (size_t)pr * PART_STRIDE);
  unsigned* flag = (unsigned*)(ws + OFF_FLAG) + pr;
  if (mode == 1) {
#pragma unroll
    for (int dt = 0; dt < 4; ++dt)
#pragma unroll
      for (int r = 0; r < 16; ++r) part[(dt * 16 + r) * 256 + tid] = o[dt][r];
    part[16384 + tid] = m; part[16384 + 256 + tid] = l;
    asm volatile("s_waitcnt vmcnt(0)" ::: "memory");
    __syncthreads();
    if (tid == 0) {
      __builtin_amdgcn_fence(__ATOMIC_RELEASE, "agent");
      asm volatile("s_waitcnt vmcnt(0)" ::: "memory");
      __hip_atomic_store(flag, 1u, __ATOMIC_RELAXED, __HIP_MEMORY_SCOPE_AGENT);
    }
    return;
  }
  if (mode == 2) {
    if (tid == 0) {
      unsigned sp = 0;
      while (__hip_atomic_load(flag, __ATOMIC_RELAXED, __HIP_MEMORY_SCOPE_AGENT) == 0u) { __builtin_amdgcn_s_sleep(2); if (++sp > (1u << 22)) break; }
      __builtin_amdgcn_fence(__ATOMIC_ACQUIRE, "agent");
      asm volatile("s_waitcnt vmcnt(0)" ::: "memory");
    }
    __syncthreads();
    const float mb = part[16384 + tid], lb = part[16384 + 256 + tid];
    const float mm = fmaxf(m, mb), fa = __builtin_amdgcn_exp2f(m - mm), fb = __builtin_amdgcn_exp2f(mb - mm);
    l = l * fa + lb * fb;
#pragma unroll
    for (int dt = 0; dt < 4; ++dt)
#pragma unroll
      for (int r = 0; r < 16; ++r) o[dt][r] = o[dt][r] * fa + part[(dt * 16 + r) * 256 + tid] * fb;
  }
  l = xhalf_sum(l);
  attn_store(o, 1.f / l, (const u16*)(ws + OFF_GATE), (u16*)(ws + OFF_MIXED), tok2, 1024 + head * 128, h);
}

constexpr float SB_DONE = -120.f;
DI void sb_block32(f32x16& s, float& c, int key0, int tok, int h) {
  constexpr float SC = 0.08838834764831845f;
  float lk[16];
#pragma unroll
  for (int r = 0; r < 16; ++r) {
    const int key = key0 + (r & 3) + 8 * (r >> 2) + 4 * h;
    const float z = s[r] * SC;
    const float sp = fmaxf(z, 0.f) + __logf(1.f + __expf(-fabsf(z)));
    const bool valid = key < tok;
    lk[r] = valid ? -sp : 0.f;
    s[r] = valid ? (z - sp) : -1e30f;
  }
  float G[4], PG[4], T[4];
#pragma unroll
  for (int g = 0; g < 4; ++g) { G[g] = (lk[4 * g] + lk[4 * g + 1]) + (lk[4 * g + 2] + lk[4 * g + 3]); PG[g] = xhalf_other(G[g], h); T[g] = G[g] + PG[g]; }
  float ST[4]; ST[3] = 0.f; ST[2] = T[3]; ST[1] = T[3] + T[2]; ST[0] = ST[1] + T[1];
  const float total = ST[0] + T[0];
#pragma unroll
  for (int g = 0; g < 4; ++g) {
    const float base = c + ST[g] + (h == 0 ? PG[g] : 0.f);
    const float l3 = base, l2 = l3 + lk[4 * g + 3], l1 = l2 + lk[4 * g + 2], l0 = l1 + lk[4 * g + 1];
    s[4 * g + 3] = __expf(s[4 * g + 3] + l3); s[4 * g + 2] = __expf(s[4 * g + 2] + l2);
    s[4 * g + 1] = __expf(s[4 * g + 1] + l1); s[4 * g]     = __expf(s[4 * g] + l0);
  }
  c += total;
}
DI void sb_item(const Params& p, int head, int qb, char* lds) {
  unsigned char* ws = p.ws;
  const int tid = fresh_tid(), wid = __builtin_amdgcn_readfirstlane(tid >> 6), lane = tid & 63, r32 = lane & 31, h = lane >> 5;
  const u16* Q = (const u16*)(ws + OFF_SBQ); const u16* Kg = (const u16*)(ws + OFF_SBK); const u16* VT = (const u16*)(ws + OFF_SBVT);
  const int tok = qb * 128 + wid * 32 + r32, tokmax = qb * 128 + wid * 32 + 31;
  unsigned qoff = (unsigned)((tok * 1024 + head * 128 + h * 8) * 2);
  f32x16 o[4];
#pragma unroll
  for (int dt = 0; dt < 4; ++dt)
#pragma unroll
    for (int r = 0; r < 16; ++r) o[dt][r] = 0.f;
  float c = 0.f; int wdone = 0;
  u32x4 kreg[4], vreg[4];
  const int srow = tid >> 3, sc = tid & 7;
  const unsigned k_off = (unsigned)((srow * 1024 + sc * 8) * 2);
  char* kw = lds + srow * 256 + ((sc ^ (srow & 15)) << 4);
#define K_LOAD(t) do { const char* a_ = (const char*)(Kg + (size_t)(t) * 64 * 1024 + head * 128); kreg[0] = *(const u32x4*)(a_ + k_off); kreg[1] = *(const u32x4*)(a_ + 128 + k_off); \
    kreg[2] = *(const u32x4*)(a_ + 32 * 2048 + k_off); kreg[3] = *(const u32x4*)(a_ + 32 * 2048 + 128 + k_off); } while (0)
#define K_WRITE() do { char* kw2_ = (char*)((size_t)kw ^ 128); *(u32x4*)(kw) = kreg[0]; *(u32x4*)(kw2_) = kreg[1]; \
    *(u32x4*)(kw + 32 * 256) = kreg[2]; *(u32x4*)(kw2_ + 32 * 256) = kreg[3]; } while (0)
  const int T0 = 2 * qb + 1;
  K_LOAD(T0); vt_load(vreg, VT, head, T0 * 64, tid);
  volatile int* flags = (volatile int*)(lds + LDS_MISC + 16);
  const char* kb0 = lds + r32 * 256;
  const int sw = r32 & 15;
  for (int t = T0; t >= 0; --t) {
    if (lane == 0) flags[wid] = wdone;
    __syncthreads();
    if (flags[0] & flags[1] & flags[2] & flags[3]) break;
    K_WRITE(); vt_write<SB_VT>(vreg, lds, tid);
    __syncthreads();
    bf16x8 pf[2][2];
    const bool act = (t * 64 < tokmax) && !wdone;
    if (act) {
      bf16x8 qf[8];
      asm volatile("" : "+v"(qoff));
#pragma unroll
      for (int ks = 0; ks < 8; ++ks) qf[ks] = *(const bf16x8*)((const char*)Q + qoff + ks * 32);
      {
        f32x16 s1;
#pragma unroll
        for (int r = 0; r < 16; ++r) s1[r] = 0.f;
#pragma unroll
        for (int ks = 0; ks < 8; ++ks) s1 = MFMA(*(const bf16x8*)(kb0 + 32 * 256 + (((2 * ks + h) ^ sw) << 4)), qf[ks], s1);
        sb_block32(s1, c, t * 64 + 32, tok, h);
        pf[1][0] = pack8(s1, 0); pf[1][1] = pack8(s1, 1);
      }
      __builtin_amdgcn_sched_barrier(0);
      {
        f32x16 s0;
#pragma unroll
        for (int r = 0; r < 16; ++r) s0[r] = 0.f;
#pragma unroll
        for (int ks = 0; ks < 8; ++ks) s0 = MFMA(*(const bf16x8*)(kb0 + (((2 * ks + h) ^ sw) << 4)), qf[ks], s0);
        sb_block32(s0, c, t * 64, tok, h);
        pf[0][0] = pack8(s0, 0); pf[0][1] = pack8(s0, 1);
      }
    }
    if (t > 0) { K_LOAD(t - 1); vt_load(vreg, VT, head, (t - 1) * 64, tid); }
    if (act) { pv_tile<SB_VT>(o, pf, lds, r32, h); wdone = __all(c < SB_DONE) ? 1 : 0; }
  }
#undef K_LOAD
#undef K_WRITE
  int tok2 = tok; asm volatile("" : "+v"(tok2));
  attn_store(o, 1.f, (const u16*)(ws + OFF_GATE), (u16*)(ws + OFF_MIXED), tok2, head * 128, h);
}

struct TDesc { const float* src; const float* scale; u16* dst; int K, N, k0, n0, rows; };
DI TDesc tile_desc(const Params& p, int t) {
  constexpr int T_IN = 32 * 94, T_OUT = 32 * 32, T_Q = 8 * 24;
  unsigned char* ws = p.ws; TDesc d;
  if (t < T_IN) { const int kt = t / 94, nt = t - kt * 94; d = {p.w_in, p.pre_w, (u16*)(ws + OFF_WINT), DM, DIN, kt * 64, nt * 64, DINP}; }
  else if (t < T_IN + T_OUT) { const int u = t - T_IN; d = {p.w_out, nullptr, (u16*)(ws + OFF_WOT), 2048, 2048, (u >> 5) * 64, (u & 31) * 64, 2048}; }
  else if (t < T_IN + T_OUT + T_Q) { const int u = t - T_IN - T_OUT, kt = u / 24, nt = u - kt * 24; d = {p.w_qup, p.qn_w, (u16*)(ws + OFF_WQT), 512, 1536, kt * 64, nt * 64, 1536}; }
  else { const int u = t - T_IN - T_OUT - T_Q; d = {p.w_kvup, p.kvn_w, (u16*)(ws + OFF_WKVT), 256, 2048, (u >> 5) * 64, (u & 31) * 64, 2048}; }
  return d;
}
DI void tr_load(f32x4 (&reg)[4], float (&sc)[4], const TDesc& d, int tid) {
#pragma unroll
  for (int i = 0; i < 4; ++i) {
    const int idx = tid + 256 * i, kk = idx >> 4, n4 = (idx & 15) * 4;
    if (d.n0 < d.N) { reg[i] = *(const f32x4*)(d.src + (size_t)(d.k0 + kk) * d.N + d.n0 + n4); sc[i] = d.scale ? d.scale[d.k0 + kk] : 1.f; }
    else { reg[i] = f32x4{0.f, 0.f, 0.f, 0.f}; sc[i] = 0.f; }
  }
}
DI void phase0(const Params& p, char* lds) {
  unsigned char* ws = p.ws;
  const int tid = fresh_tid(), wid = __builtin_amdgcn_readfirstlane(tid >> 6), lane = tid & 63, nb = gridDim.x, bid = blockIdx.x;
  if (bid == 0) { unsigned* ctr = (unsigned*)(ws + OFF_CTR); if (tid < 16) ctr[tid] = 0u; ((unsigned*)(ws + OFF_FLAG))[tid] = 0u; }
  {
    constexpr int NT = 32 * 94 + 32 * 32 + 8 * 24 + 4 * 32;
    float* tl = (float*)lds;
    f32x4 reg[4]; float sc[4];
    int t = bid; TDesc d = tile_desc(p, t < NT ? t : 0);
    if (t < NT) tr_load(reg, sc, d, tid);
    while (t < NT) {
      __syncthreads();
#pragma unroll
      for (int i = 0; i < 4; ++i) {
        const int idx = tid + 256 * i, kk = idx >> 4, n4 = (idx & 15) * 4;
#pragma unroll
        for (int j = 0; j < 4; ++j) tl[kk * 65 + n4 + j] = reg[i][j] * sc[i];
      }
      __syncthreads();
      const TDesc dc = d;
      const int tn = t + nb;
      if (tn < NT) { d = tile_desc(p, tn); tr_load(reg, sc, d, tid); }
#pragma unroll
      for (int i = 0; i < 2; ++i) {
        const int idx = tid + 256 * i, nn = idx >> 3, m = idx & 7;
        const float* c0 = tl + (8 * m) * 65 + nn;
        u32x4 w = {pack2(c0[0], c0[65]), pack2(c0[130], c0[195]), pack2(c0[260], c0[325]), pack2(c0[390], c0[455])};
        *(u32x4*)(dc.dst + kblk(dc.rows, dc.n0 + nn, dc.k0 + 8 * m)) = w;
      }
      t = tn;
    }
  }
  float* COS = (float*)(ws + OFF_COS); float* SIN = (float*)(ws + OFF_SIN);
  for (int idx = bid * 256 + tid; idx < S * 32; idx += nb * 256) {
    const int tok = idx >> 5, i = idx & 31;
    const float inv = exp2f(-(float)i * (13.287712379549449f / 32.f));
    const float ang = (float)p.pos[tok] * inv;
    const double a = (double)ang * 0.15915494309189535;
    const float rev = (float)(a - rint(a));
    COS[idx] = __builtin_amdgcn_cosf(rev); SIN[idx] = __builtin_amdgcn_sinf(rev);
  }
  u16* XB = (u16*)(ws + OFF_XB); float* rstdx = (float*)(ws + OFF_RSTDX);
  for (int row = (bid * 4 + wid) * 2; row < S; row += nb * 8) {
    const f32x4* xr = (const f32x4*)(p.x + (size_t)row * DM);
    f32x4 v[16]; float ss0 = 0.f, ss1 = 0.f;
#pragma unroll
    for (int i = 0; i < 16; ++i) v[i] = xr[lane + 64 * i];
#pragma unroll
    for (int i = 0; i < 8; ++i) { ss0 += v[i][0] * v[i][0] + v[i][1] * v[i][1] + v[i][2] * v[i][2] + v[i][3] * v[i][3]; ss1 += v[i + 8][0] * v[i + 8][0] + v[i + 8][1] * v[i + 8][1] + v[i + 8][2] * v[i + 8][2] + v[i + 8][3] * v[i + 8][3]; }
    ss0 = wave_sum(ss0, lane); ss1 = wave_sum(ss1, lane);
    if (lane == 0) { rstdx[row] = rsqrtf(ss0 * (1.f / 2048.f) + EPS); rstdx[row + 1] = rsqrtf(ss1 * (1.f / 2048.f) + EPS); }
#pragma unroll
    for (int i = 0; i < 16; ++i) store4bf(XB + kblk(S, row + (i >> 3), ((lane + 64 * i) * 4) & 2047), v[i][0], v[i][1], v[i][2], v[i][3]);
  }
}

DI void phase5(const Params& p) {
  const int tid = fresh_tid(), wid = __builtin_amdgcn_readfirstlane(tid >> 6), lane = tid & 63, nb = gridDim.x, bid = blockIdx.x;
  const float* yss = (const float*)(p.ws + OFF_YSS); const u16* Y = (const u16*)(p.ws + OFF_Y);
  const f32x4* wv = (const f32x4*)p.post_w;
  for (int row = (bid * 4 + wid) * 4; row < S; row += nb * 16) {
    const f32x4* xr = (const f32x4*)(p.x + (size_t)row * DM);
    const u32x2* yr = (const u32x2*)(Y + (size_t)row * DM);
    f32x4 xv[32]; u32x2 yv[32];
#pragma unroll
    for (int i = 0; i < 32; ++i) { xv[i] = xr[lane + 64 * i]; yv[i] = yr[lane + 64 * i]; }
    float rs[4];
#pragma unroll
    for (int r = 0; r < 4; ++r) rs[r] = rsqrtf(wave_sum(lane < 32 ? yss[(size_t)(row + r) * 32 + lane] : 0.f, lane) * (1.f / 2048.f) + EPS);
    f32x4* orow = (f32x4*)(p.out + (size_t)row * DM);
#pragma unroll
    for (int i = 0; i < 32; ++i) {
      const float r_ = rs[i >> 3]; const f32x4 ww = wv[lane + 64 * (i & 7)];
      f32x4 o_ = {xv[i][0] + bflo(yv[i][0]) * r_ * ww[0], xv[i][1] + bfhi(yv[i][0]) * r_ * ww[1], xv[i][2] + bflo(yv[i][1]) * r_ * ww[2], xv[i][3] + bfhi(yv[i][1]) * r_ * ww[3]};
      orow[lane + 64 * i] = o_;
    }
  }
}

#define XB_TMO      128
#define XB_XCNT(j)  (256  + 64 * (j))
#define XB_XSUB(j)  (1280 + 64 * (j))
#define XB_XGEN(j)  (2304 + 64 * (j))
#define XB_TOP      3328
#define XB_TOPGEN   3392
#define XCD_BAR_WORDS 3456
#define XB_SPIN_CAP (1u << 20)
#define LAS __attribute__((address_space(3)))
DI unsigned xb_ld(unsigned* p)              { return __hip_atomic_load(p, __ATOMIC_RELAXED, __HIP_MEMORY_SCOPE_AGENT); }
DI unsigned xb_add(unsigned* p, unsigned v) { return __hip_atomic_fetch_add(p, v, __ATOMIC_RELAXED, __HIP_MEMORY_SCOPE_AGENT); }
DI unsigned xb_xcc_id() { return (unsigned)__builtin_amdgcn_s_getreg((3 << 11) | 20) & 0xFu; }
#define XB_SPIN(cond, bar) do { unsigned _sp = 0; while (cond) { __builtin_amdgcn_s_sleep(1); \
    if ((++_sp & 255u) == 0u) { if (xb_ld(&(bar)[XB_TMO])) break; if (_sp > XB_SPIN_CAP) { atomicAdd(&(bar)[XB_TMO], 1u); break; } } } } while (0)
struct XcdBarrier { unsigned* bar; unsigned x; volatile LAS unsigned* st; };
DI XcdBarrier xcd_barrier_post(unsigned* bar, volatile LAS unsigned* st) {
  XcdBarrier b; b.bar = bar; b.x = xb_xcc_id(); b.st = st;
  if (threadIdx.x == 0) (void)xb_add(&bar[XB_XCNT(b.x)], 1u);
  return b;
}
DI void xcd_barrier_complete(unsigned* bar, unsigned x, unsigned& nloc, unsigned& nx) {
  const unsigned G = gridDim.x * gridDim.y * gridDim.z;
  unsigned sum, cnt, mine, sp = 0u;
  for (;;) {
    sum = 0u; cnt = 0u; mine = 0u;
#pragma unroll
    for (unsigned j = 0; j < 16; ++j) { const unsigned c = xb_ld(&bar[XB_XCNT(j)]); sum += c; cnt += (c > 0u) ? 1u : 0u; mine = (j == x) ? c : mine; }
    if (sum == G) break;
    __builtin_amdgcn_s_sleep(1);
    if ((++sp & 255u) == 0u) { if (xb_ld(&bar[XB_TMO])) break; if (sp > XB_SPIN_CAP) { atomicAdd(&bar[XB_TMO], 1u); break; } }
  }
  nloc = mine > 0u ? mine : 1u; nx = cnt > 0u ? cnt : 1u;
}
DI void xcd_barrier(const XcdBarrier& b) {
  asm volatile("s_waitcnt vmcnt(0)" ::: "memory");
  __syncthreads();
  if (threadIdx.x == 0) {
    unsigned* bar = b.bar;
    __builtin_amdgcn_s_waitcnt(0);
    unsigned nloc = b.st[0], nx = b.st[1];
    if (nloc == 0u) { xcd_barrier_complete(bar, b.x, nloc, nx); b.st[0] = nloc; b.st[1] = nx; }
    const unsigned old = xb_add(&bar[XB_XSUB(b.x)], 1u);
    const unsigned gen = old / nloc;
    if (old + 1u == (gen + 1u) * nloc) {
      __builtin_amdgcn_fence(__ATOMIC_RELEASE, "agent");
      asm volatile("s_waitcnt vmcnt(0)" ::: "memory");
      const unsigned og = xb_add(&bar[XB_TOP], 1u);
      const unsigned tg = og / nx;
      if (og + 1u == (tg + 1u) * nx) xb_add(&bar[XB_TOPGEN], 1u);
      else XB_SPIN(xb_ld(&bar[XB_TOPGEN]) == tg, bar);
      __builtin_amdgcn_fence(__ATOMIC_ACQUIRE, "agent");
      xb_add(&bar[XB_XGEN(b.x)], 1u);
      asm volatile("s_waitcnt vmcnt(0)" ::: "memory");
    } else {
      XB_SPIN(xb_ld(&bar[XB_XGEN(b.x)]) == gen, bar);
      __builtin_amdgcn_fence(__ATOMIC_ACQUIRE, "agent");
      asm volatile("s_waitcnt vmcnt(0)" ::: "memory");
    }
  }
  __syncthreads();
}

__global__ void __launch_bounds__(256, 2) fwd_megakernel(Params p) {
  extern __shared__ __attribute__((aligned(16))) char lds[];
  cg::grid_group grid = cg::this_grid();
  const int nb = gridDim.x, bid = blockIdx.x;
  if (p.ws == nullptr) grid.sync();
  volatile LAS unsigned* bst = (volatile LAS unsigned*)(lds + LDS_BARST);
  if (threadIdx.x == 0) { bst[0] = 0u; bst[1] = 0u; }
  __syncthreads();
  const XcdBarrier xb = xcd_barrier_post((unsigned*)(p.ws + OFF_BAR), bst);

  phase0(p, lds);
  xcd_barrier(xb);

  for (int t = bid; t < 32 * 47; t += nb) p1_tile(p, t & 31, t >> 5, lds);
  xcd_barrier(xb);

  for (int t = bid; t < 32 * 12 + 32 * 16; t += nb) {
    if (t < 32 * 12) p2_q_tile(p, t & 31, t >> 5, lds);
    else { const int u = t - 32 * 12; p2_kv_tile(p, u & 31, u >> 5, lds); }
  }
  xcd_barrier(xb);

  for (int it = 511 - bid; it >= 0; it -= nb) {
    const int half = it >> 8, j = (it & 255) >> 3, head = it & 7, pr = it & 255;
    if (half == 0) mla_item(p, head, 63 - j, 0, 65, 2, pr, lds);
    else {
#pragma unroll 1
      for (int seg = 0; seg < 2; ++seg) mla_item(p, head, seg ? j : 63 - j, seg ? 0 : 65, seg ? 2 * j + 2 : 128 - 2 * j, seg ? 0 : 1, pr, lds);
    }
  }
  {
    unsigned* ctr = (unsigned*)(p.ws + OFF_CTR);
    volatile int* itemw = (volatile int*)(lds + LDS_MISC);
    for (;;) {
      __syncthreads();
      if (threadIdx.x == 0) *itemw = (int)atomicAdd(ctr, 1u);
      __syncthreads();
      const int it = *itemw;
      if (it >= 512) break;
      sb_item(p, it & 7, 63 - (it >> 3), lds);
    }
  }
  xcd_barrier(xb);

  for (int t = bid; t < 32 * 16; t += nb) p4_tile(p, t & 31, t >> 5, lds);
  xcd_barrier(xb);

  phase5(p);
}

extern "C" void kernel_launch(void* const* d_in, const int* in_sizes, int n_in, void* d_out, int out_size, void* d_ws, size_t ws_size, hipStream_t stream) {
  static int grid_blocks = 0;
  if (grid_blocks == 0) {
    if (n_in != 10 || in_sizes[0] != S * DM || out_size != S * DM || ws_size < WS_END) {
      fprintf(stderr, "kernel_launch: unexpected shapes n_in %d in0 %d out %d ws %zu (need %zu)\n", n_in, n_in > 0 ? in_sizes[0] : -1, out_size, ws_size, (size_t)WS_END);
      grid_blocks = -1; return;
    }
    int dev = 0, cus = 0, per_cu = 0;
    hipGetDevice(&dev);
    hipDeviceGetAttribute(&cus, hipDeviceAttributeMultiprocessorCount, dev);
    hipFuncSetAttribute((const void*)fwd_megakernel, hipFuncAttributeMaxDynamicSharedMemorySize, LDS_BYTES);
    hipOccupancyMaxActiveBlocksPerMultiprocessor(&per_cu, (const void*)fwd_megakernel, 256, LDS_BYTES);
    if (per_cu < 1) per_cu = 1;
    if (per_cu > 2) per_cu = 2;
    grid_blocks = cus * per_cu;
  }
  if (grid_blocks < 0) return;
  Params p{};
  p.x = (const float*)d_in[0]; p.pos = (const int*)d_in[1]; p.pre_w = (const float*)d_in[2]; p.w_in = (const float*)d_in[3];
  p.qn_w = (const float*)d_in[4]; p.w_qup = (const float*)d_in[5]; p.kvn_w = (const float*)d_in[6]; p.w_kvup = (const float*)d_in[7];
  p.w_out = (const float*)d_in[8]; p.post_w = (const float*)d_in[9]; p.out = (float*)d_out; p.ws = (unsigned char*)d_ws;
  if (hipMemsetAsync((char*)d_ws + OFF_BAR, 0, XCD_BAR_WORDS * 4, stream) != hipSuccess) { fprintf(stderr, "kernel_launch: memset of barrier words failed\n"); return; }
  void* args[] = {&p};
  hipError_t e = hipLaunchCooperativeKernel((const void*)fwd_megakernel, dim3(grid_blocks), dim3(256), args, LDS_BYTES, stream);
  if (e != hipSuccess) fprintf(stderr, "cooperative launch failed: %s (grid %d)\n", hipGetErrorString(e), grid_blocks);
}
```

```cpp
#include <hip/hip_runtime.h>
#include <hip/hip_cooperative_groups.h>
#include <cstdio>
namespace cg = cooperative_groups;

#define DI __device__ __forceinline__
typedef unsigned short u16;
using bf16x8 = __attribute__((ext_vector_type(8))) short;
using f32x16 = __attribute__((ext_vector_type(16))) float;
using f32x4  = __attribute__((ext_vector_type(4))) float;
using f32x2  = __attribute__((ext_vector_type(2))) float;
using u32x4  = __attribute__((ext_vector_type(4))) unsigned;
using u32x2  = __attribute__((ext_vector_type(2))) unsigned;
typedef __bf16 bf16x2_t __attribute__((ext_vector_type(2)));

constexpr int S = 8192, DM = 2048, DIN = 5952, DINP = 6016;
constexpr float EPS = 1e-6f;

constexpr size_t OFF_XB    = 0;
constexpr size_t OFF_WINT  = OFF_XB   + (size_t)S * DM * 2;
constexpr size_t OFF_WQT   = OFF_WINT + (size_t)DINP * DM * 2;
constexpr size_t OFF_WKVT  = OFF_WQT  + (size_t)1536 * 512 * 2;
constexpr size_t OFF_WOT   = OFF_WKVT + (size_t)2048 * 256 * 2;
constexpr size_t OFF_RSTDX = OFF_WOT  + (size_t)2048 * 2048 * 2;
constexpr size_t OFF_COS   = OFF_RSTDX + (size_t)S * 4;
constexpr size_t OFF_SIN   = OFF_COS  + (size_t)S * 32 * 4;
constexpr size_t OFF_SBQ   = OFF_SIN  + (size_t)S * 32 * 4;
constexpr size_t OFF_SBK   = OFF_SBQ  + (size_t)S * 1024 * 2;
constexpr size_t OFF_SBVT  = OFF_SBK  + (size_t)S * 1024 * 2;
constexpr size_t OFF_GATE  = OFF_SBVT + (size_t)S * 1024 * 2;
constexpr size_t OFF_CQ    = OFF_GATE + (size_t)S * 2048 * 2;
constexpr size_t OFF_CKV   = OFF_CQ   + (size_t)S * 512 * 2;
constexpr size_t OFF_KROT  = OFF_CKV  + (size_t)S * 256 * 2;
constexpr size_t OFF_CQSS  = OFF_KROT + (size_t)S * 64 * 2;
constexpr size_t OFF_CKVSS = OFF_CQSS + (size_t)S * 8 * 4;
constexpr size_t OFF_QMLA  = OFF_CKVSS + (size_t)S * 4 * 4;
constexpr size_t OFF_KNOPE = OFF_QMLA + (size_t)S * 1536 * 2;
constexpr size_t OFF_MVT   = OFF_KNOPE + (size_t)S * 1024 * 2;
constexpr size_t OFF_YSS   = OFF_MVT  + (size_t)S * 1024 * 2;
constexpr size_t OFF_CTR   = OFF_YSS  + (size_t)S * 32 * 4;
constexpr size_t OFF_BAR   = OFF_CTR + 2048;
constexpr size_t WS_END    = OFF_BAR + 16384;
constexpr size_t OFF_MIXED = OFF_XB;
constexpr size_t OFF_PART  = OFF_WINT;
constexpr size_t PART_STRIDE = 65536 + 2048;
static_assert(256 * PART_STRIDE <= (size_t)DINP * DM * 2, "partials must fit in the dead w_in^T region");
constexpr size_t OFF_FLAG  = OFF_CTR + 64;
constexpr size_t OFF_Y     = OFF_SBQ;

constexpr int LDS_BYTES = 73728 + 256;
constexpr int LDS_BARST = 73728;

struct Params {
  const float* x; const int* pos; const float* pre_w; const float* w_in; const float* qn_w; const float* w_qup;
  const float* kvn_w; const float* w_kvup; const float* w_out; const float* post_w; float* out; unsigned char* ws;
};

DI unsigned pack2(float lo, float hi) { f32x2 v = {lo, hi}; bf16x2_t r = __builtin_convertvector(v, bf16x2_t); return __builtin_bit_cast(unsigned, r); }
DI float bflo(unsigned w) { return __uint_as_float(w << 16); }
DI float bfhi(unsigned w) { return __uint_as_float(w & 0xffff0000u); }
DI void store4bf(u16* dst, float a, float b, float c, float d) { u32x2 v = {pack2(a, b), pack2(c, d)}; *(u32x2*)dst = v; }
DI float xhalf_sum(float v) { auto rr = __builtin_amdgcn_permlane32_swap(__float_as_uint(v), __float_as_uint(v), false, false); return __uint_as_float(rr[0]) + __uint_as_float(rr[1]); }
DI float xhalf_max(float v) { auto rr = __builtin_amdgcn_permlane32_swap(__float_as_uint(v), __float_as_uint(v), false, false); return fmaxf(__uint_as_float(rr[0]), __uint_as_float(rr[1])); }
DI float xhalf_other(float v, int h) { auto rr = __builtin_amdgcn_permlane32_swap(__float_as_uint(v), __float_as_uint(v), false, false); return __uint_as_float(h ? rr[0] : rr[1]); }
DI float wave_sum(float v, int lane) {
#pragma unroll
  for (int o = 32; o > 0; o >>= 1) v += __int_as_float(__builtin_amdgcn_ds_bpermute((lane ^ o) << 2, __float_as_int(v)));
  return v;
}
DI int fresh_tid() { int t = threadIdx.x; asm volatile("" : "+v"(t)); return t; }
DI float silu(float v) { return v * __builtin_amdgcn_rcpf(1.f + __builtin_amdgcn_exp2f(-1.4426950408889634f * v)); }
DI void dma16(const void* gsrc, char* lds_wave_base) { __builtin_amdgcn_global_load_lds((const unsigned*)gsrc, (unsigned*)lds_wave_base, 16, 0, 0); }

template <int OFF> DI void ds_rd128(bf16x8& dst, unsigned addr) { asm volatile("ds_read_b128 %0, %1 offset:%2" : "=v"(dst) : "v"(addr), "i"(OFF)); }
template <int OFF> DI void ds_rd64(u32x2& dst, unsigned addr)  { asm volatile("ds_read_b64 %0, %1 offset:%2" : "=v"(dst) : "v"(addr), "i"(OFF)); }
template <int N> DI void lgkm_wait1(bf16x8& a) { asm volatile("s_waitcnt lgkmcnt(%1)" : "+v"(a) : "i"(N)); }
template <int N> DI void lgkm_wait2(bf16x8& a, bf16x8& b) { asm volatile("s_waitcnt lgkmcnt(%2)" : "+v"(a), "+v"(b) : "i"(N)); }
template <int N> DI void lgkm_wait2(u32x2& a, u32x2& b)   { asm volatile("s_waitcnt lgkmcnt(%2)" : "+v"(a), "+v"(b) : "i"(N)); }

DI u32x4 widen16(u32x2 a, u32x2 b) {
  auto r0 = __builtin_amdgcn_permlane32_swap(a[0], b[0], false, false);
  auto r1 = __builtin_amdgcn_permlane32_swap(a[1], b[1], false, false);
  u32x4 w = {r0[0], r1[0], r0[1], r1[1]};
  return w;
}
#define MFMA(a, b, c) __builtin_amdgcn_mfma_f32_32x32x16_bf16((a), (b), (c), 0, 0, 0)

constexpr int GM = 256, GN = 128, G_STAGE_B = 24576;
DI size_t kblk(int rows, int row, int k) { return ((size_t)(k >> 5) * rows + row) * 32 + (k & 31); }
template <bool SWAP>
DI void gemm_mainloop(f32x16 (&acc)[4][2], const u16* __restrict__ A, int lda, const u16* __restrict__ Bt, int ldb, int K, int m0, int n0, char* lds) {
  const int tid = fresh_tid(), wid = __builtin_amdgcn_readfirstlane(tid >> 6), lane = tid & 63, r32 = lane & 31, h = lane >> 5, wr = wid >> 1, wc = wid & 1;
#pragma unroll
  for (int a = 0; a < 4; ++a)
#pragma unroll
    for (int b = 0; b < 2; ++b)
#pragma unroll
      for (int r = 0; r < 16; ++r) acc[a][b][r] = 0.f;
  const int srow = wid * 16 + (lane >> 2);
  const int schunk = (lane & 3) ^ ((lane >> 4) & 3);
  const char* Ab = (const char*)(A + (size_t)m0 * 32);
  const char* Bb = (const char*)(Bt + (size_t)n0 * 32);
  const unsigned aoff = (unsigned)((srow * 32 + schunk * 8) * 2), boff = aoff;
  const size_t astage = (size_t)lda * 64, bstage = (size_t)ldb * 64;
  char* dbase = lds + wid * 1024;
#define G_DMA(bufoff, s_) do { const char* a_ = Ab + (size_t)(s_) * astage + aoff; const char* b_ = Bb + (size_t)(s_) * bstage + boff; \
    _Pragma("unroll") for (int i = 0; i < 4; ++i) dma16(a_ + i * 4096, dbase + (bufoff) + i * 4096); \
    _Pragma("unroll") for (int i = 0; i < 2; ++i) dma16(b_ + i * 4096, dbase + (bufoff) + 16384 + i * 4096); } while (0)
  const int nk = K >> 5;
  __syncthreads();
  G_DMA(0, 0);
  asm volatile("s_waitcnt vmcnt(0)" ::: "memory");
  __syncthreads();
  const int swz = (r32 >> 2) & 3;
  const int arow = (wr * 128 + r32) * 64, brow = 16384 + (wc * 64 + r32) * 64;
  bf16x8 af[2][4], bfr[2][2];
#define F_READ(set, St_) do { const int co_ = ((2 * (set) + h) ^ swz) << 4; \
    _Pragma("unroll") for (int t = 0; t < 4; ++t) af[set][t] = *(const bf16x8*)((St_) + arow + t * 2048 + co_); \
    _Pragma("unroll") for (int t = 0; t < 2; ++t) bfr[set][t] = *(const bf16x8*)((St_) + brow + t * 2048 + co_); } while (0)
#define F_MMA(set) do { _Pragma("unroll") for (int mt = 0; mt < 4; ++mt) _Pragma("unroll") for (int nt = 0; nt < 2; ++nt) \
    acc[mt][nt] = SWAP ? MFMA(af[set][mt], bfr[set][nt], acc[mt][nt]) : MFMA(bfr[set][nt], af[set][mt], acc[mt][nt]); } while (0)
#pragma unroll 1
  for (int s_ = 0; s_ < nk; ++s_) {
    const int cur = (s_ & 1) * G_STAGE_B, nxt = G_STAGE_B - cur;
    const char* St = lds + cur;
    if (s_ + 1 < nk) G_DMA(nxt, s_ + 1);
    __builtin_amdgcn_sched_barrier(0);
    F_READ(0, St);
    __builtin_amdgcn_sched_barrier(0);
    if (s_ > 0) F_MMA(1);
    __builtin_amdgcn_sched_barrier(0);
    F_READ(1, St);
    __builtin_amdgcn_sched_barrier(0);
    F_MMA(0);
    __builtin_amdgcn_sched_barrier(0);
    asm volatile("s_waitcnt vmcnt(0)" ::: "memory");
    __syncthreads();
  }
  F_MMA(1);
#undef F_READ
#undef F_MMA
#undef G_DMA
}

template <bool SILU, bool KB = false>
DI void store_strip(const f32x16 (&acc)[4][2], u16* base, int ld, int col0, int tok0, const float (&rs)[4], int r32, int h) {
#pragma unroll
  for (int mt = 0; mt < 4; ++mt) {
    u16* rowp = KB ? base + kblk(S, tok0 + mt * 32 + r32, col0) + 8 * h : base + (size_t)(tok0 + mt * 32 + r32) * ld + col0 + 8 * h;
    const size_t ntstep = KB ? (size_t)S * 32 : 32;
#pragma unroll
    for (int nt = 0; nt < 2; ++nt)
#pragma unroll
      for (int k = 0; k < 2; ++k) {
        u32x2 pk[2];
#pragma unroll
        for (int e = 0; e < 2; ++e) {
          const int g = 2 * k + e;
          float v0 = acc[mt][nt][4 * g] * rs[mt], v1 = acc[mt][nt][4 * g + 1] * rs[mt], v2 = acc[mt][nt][4 * g + 2] * rs[mt], v3 = acc[mt][nt][4 * g + 3] * rs[mt];
          if (SILU) { v0 = silu(v0); v1 = silu(v1); v2 = silu(v2); v3 = silu(v3); }
          pk[e][0] = pack2(v0, v1); pk[e][1] = pack2(v2, v3);
        }
        *(u32x4*)(rowp + nt * ntstep + 16 * k) = widen16(pk[0], pk[1]);
      }
    __builtin_amdgcn_sched_barrier(0);
  }
}
template <bool SILU>
DI void store_strip_rows(const f32x16 (&acc)[4][2], u16* base, int ld, int col0, int tok0, const float (&rs)[4], int r32, int h, char* lds, int wid, int lane) {
  char* wl = lds + wid * 16384;
#pragma unroll
  for (int mt = 0; mt < 4; ++mt) {
    const int row = mt * 32 + r32;
#pragma unroll
    for (int nt = 0; nt < 2; ++nt)
#pragma unroll
      for (int k = 0; k < 2; ++k) {
        u32x2 pk[2];
#pragma unroll
        for (int e = 0; e < 2; ++e) {
          const int g = 2 * k + e;
          float v0 = acc[mt][nt][4 * g] * rs[mt], v1 = acc[mt][nt][4 * g + 1] * rs[mt], v2 = acc[mt][nt][4 * g + 2] * rs[mt], v3 = acc[mt][nt][4 * g + 3] * rs[mt];
          if (SILU) { v0 = silu(v0); v1 = silu(v1); v2 = silu(v2); v3 = silu(v3); }
          pk[e][0] = pack2(v0, v1); pk[e][1] = pack2(v2, v3);
        }
        const int c = nt * 4 + 2 * k + h;
        *(u32x4*)(wl + row * 128 + ((c ^ (row & 7)) << 4)) = widen16(pk[0], pk[1]);
      }
    __builtin_amdgcn_sched_barrier(0);
  }
  const int rr = lane >> 3, c = lane & 7;
  u16* gp = base + (size_t)(tok0 + rr) * ld + col0 + c * 8;
#pragma unroll
  for (int i = 0; i < 16; ++i) {
    const int row = i * 8 + rr;
    const u32x4 v = *(const u32x4*)(wl + row * 128 + ((c ^ (row & 7)) << 4));
    *(u32x4*)(gp + (size_t)(i * 8) * ld) = v;
  }
}
DI void store_rope_strip(const f32x16 (&acc)[4][2], u16* base, int ld, int col0, int tok0, const float (&rs)[4], int r32, int h, const float* COS, const float* SIN) {
#pragma unroll
  for (int mt = 0; mt < 4; ++mt) {
    const int tok = tok0 + mt * 32 + r32;
    u16* rowp = base + (size_t)tok * ld + col0 + 4 * h;
#pragma unroll
    for (int g = 0; g < 4; ++g) {
      const f32x4 c = *(const f32x4*)(COS + (size_t)tok * 32 + 8 * g + 4 * h);
      const f32x4 s = *(const f32x4*)(SIN + (size_t)tok * 32 + 8 * g + 4 * h);
      float o1[4], o2[4];
#pragma unroll
      for (int i = 0; i < 4; ++i) {
        const float x1 = acc[mt][0][4 * g + i] * rs[mt], x2 = acc[mt][1][4 * g + i] * rs[mt];
        o1[i] = x1 * c[i] - x2 * s[i]; o2[i] = x2 * c[i] + x1 * s[i];
      }
      store4bf(rowp + 8 * g, o1[0], o1[1], o1[2], o1[3]);
      store4bf(rowp + 32 + 8 * g, o2[0], o2[1], o2[2], o2[3]);
      __builtin_amdgcn_sched_barrier(0);
    }
  }
}
DI void strip_sumsq(const f32x16 (&acc)[4][2], float* ss, int nslot, int slot, int tok0, const float (&rs)[4], int r32, int h) {
#pragma unroll
  for (int mt = 0; mt < 4; ++mt) {
    float s = 0.f;
#pragma unroll
    for (int nt = 0; nt < 2; ++nt)
#pragma unroll
      for (int r = 0; r < 16; ++r) { const float v = acc[mt][nt][r] * rs[mt]; s += v * v; }
    s = xhalf_sum(s);
    if (h == 0) ss[(size_t)(tok0 + mt * 32 + r32) * nslot + slot] = s;
  }
}
template <bool KVSS>
DI void store_strip_T(const f32x16 (&acc)[4][2], u16* baseT, int feat0, int tok0, const float* rsrc, int r32, int h) {
#pragma unroll
  for (int mt = 0; mt < 4; ++mt)
#pragma unroll
    for (int k = 0; k < 2; ++k) {
      f32x4 r4[2];
#pragma unroll
      for (int e = 0; e < 2; ++e) {
        const int tb = tok0 + mt * 32 + 8 * (2 * k + e) + 4 * h;
        if (KVSS) {
#pragma unroll
          for (int i = 0; i < 4; ++i) { const f32x4 a = *(const f32x4*)(rsrc + (size_t)(tb + i) * 4); r4[e][i] = rsqrtf(((a[0] + a[1]) + (a[2] + a[3])) * (1.f / 256.f) + EPS); }
        } else r4[e] = *(const f32x4*)(rsrc + tb);
      }
#pragma unroll
      for (int nt = 0; nt < 2; ++nt) {
        u32x2 pk[2];
#pragma unroll
        for (int e = 0; e < 2; ++e) {
          const int g = 2 * k + e;
          pk[e][0] = pack2(acc[mt][nt][4 * g] * r4[e][0], acc[mt][nt][4 * g + 1] * r4[e][1]);
          pk[e][1] = pack2(acc[mt][nt][4 * g + 2] * r4[e][2], acc[mt][nt][4 * g + 3] * r4[e][3]);
        }
        const u32x4 w_ = {pk[0][0], pk[0][1], pk[1][0], pk[1][1]};
        *(u32x4*)(baseT + (size_t)(feat0 + nt * 32 + r32) * S + tok0 + mt * 32 + 16 * k + 8 * h) = w_;
      }
    }
}

DI void p1_tile(const Params& p, int tm, int tn, char* lds) {
  unsigned char* ws = p.ws;
  const int wid = __builtin_amdgcn_readfirstlane(fresh_tid() >> 6), wr = wid >> 1, wc = wid & 1;
  const int m0 = tm * GM, n0 = tn * GN;
  const u16* A = (const u16*)(ws + OFF_XB); const u16* Bt = (const u16*)(ws + OFF_WINT);
  const float* rstdx = (const float*)(ws + OFF_RSTDX);
  const int tok0 = m0 + wr * 128;
  f32x16 acc[4][2];
  if (n0 >= 2048 && n0 < 3072) {
    gemm_mainloop<true>(acc, A, S, Bt, DINP, DM, m0, n0, lds);
    const int lane = fresh_tid() & 63, r32 = lane & 31, h = lane >> 5;
    store_strip_T<false>(acc, (u16*)(ws + OFF_SBVT), n0 - 2048 + wc * 64, tok0, rstdx, r32, h);
    return;
  }
  gemm_mainloop<false>(acc, A, S, Bt, DINP, DM, m0, n0, lds);
  const int lane = fresh_tid() & 63, r32 = lane & 31, h = lane >> 5;
  float rs[4];
#pragma unroll
  for (int mt = 0; mt < 4; ++mt) rs[mt] = rstdx[tok0 + mt * 32 + r32];
  const int fb = n0 + wc * 64;
  if (fb < 1024)      store_strip_rows<false>(acc, (u16*)(ws + OFF_SBQ), 1024, fb, tok0, rs, r32, h, lds, wid, lane);
  else if (fb < 2048) store_strip_rows<false>(acc, (u16*)(ws + OFF_SBK), 1024, fb - 1024, tok0, rs, r32, h, lds, wid, lane);
  else if (fb < 4096) store_strip_rows<true>(acc, (u16*)(ws + OFF_GATE), 2048, fb - 3072, tok0, rs, r32, h, lds, wid, lane);
  else if (fb < 4608) { store_strip<false, true>(acc, (u16*)(ws + OFF_CQ), 512, fb - 4096, tok0, rs, r32, h); strip_sumsq(acc, (float*)(ws + OFF_CQSS), 8, (fb - 4096) >> 6, tok0, rs, r32, h); }
  else if (fb < 4864) { store_strip<false, true>(acc, (u16*)(ws + OFF_CKV), 256, fb - 4608, tok0, rs, r32, h); strip_sumsq(acc, (float*)(ws + OFF_CKVSS), 4, (fb - 4608) >> 6, tok0, rs, r32, h); }
  else if (fb < 4928) store_rope_strip(acc, (u16*)(ws + OFF_KROT), 64, 0, tok0, rs, r32, h, (const float*)(ws + OFF_COS), (const float*)(ws + OFF_SIN));
  else if (fb < DIN)  store_strip_rows<true>(acc, (u16*)(ws + OFF_GATE), 2048, 1024 + fb - 4928, tok0, rs, r32, h, lds, wid, lane);
}

DI void p2_q_tile(const Params& p, int tm, int tn, char* lds) {
  unsigned char* ws = p.ws;
  const int wid = __builtin_amdgcn_readfirstlane(fresh_tid() >> 6), wr = wid >> 1, wc = wid & 1;
  const int m0 = tm * GM, n0 = tn * GN, tok0 = m0 + wr * 128;
  f32x16 acc[4][2];
  gemm_mainloop<false>(acc, (const u16*)(ws + OFF_CQ), S, (const u16*)(ws + OFF_WQT), 1536, 512, m0, n0, lds);
  const int lane = fresh_tid() & 63, r32 = lane & 31, h = lane >> 5;
  const float* ssq = (const float*)(ws + OFF_CQSS);
  float rs[4];
#pragma unroll
  for (int mt = 0; mt < 4; ++mt) {
    const f32x4 a = *(const f32x4*)(ssq + (size_t)(tok0 + mt * 32 + r32) * 8), b = *(const f32x4*)(ssq + (size_t)(tok0 + mt * 32 + r32) * 8 + 4);
    rs[mt] = rsqrtf(((a[0] + a[1]) + (a[2] + a[3]) + (b[0] + b[1]) + (b[2] + b[3])) * (1.f / 512.f) + EPS);
  }
  const int fb = n0 + wc * 64;
  if ((fb % 192) == 128) store_rope_strip(acc, (u16*)(ws + OFF_QMLA), 1536, fb, tok0, rs, r32, h, (const float*)(ws + OFF_COS), (const float*)(ws + OFF_SIN));
  else                   store_strip_rows<false>(acc, (u16*)(ws + OFF_QMLA), 1536, fb, tok0, rs, r32, h, lds, wid, lane);
}
DI float kv_rstd(const float* sskv, int tok) { const f32x4 a = *(const f32x4*)(sskv + (size_t)tok * 4); return rsqrtf(((a[0] + a[1]) + (a[2] + a[3])) * (1.f / 256.f) + EPS); }
DI void p2_kv_tile(const Params& p, int tm, int tn, char* lds) {
  unsigned char* ws = p.ws;
  const int wid = __builtin_amdgcn_readfirstlane(fresh_tid() >> 6), wr = wid >> 1, wc = wid & 1;
  const int m0 = tm * GM, n0 = tn * GN, tok0 = m0 + wr * 128, hd = n0 >> 8;
  const float* sskv = (const float*)(ws + OFF_CKVSS);
  f32x16 acc[4][2];
  if (n0 & 128) {
    gemm_mainloop<true>(acc, (const u16*)(ws + OFF_CKV), S, (const u16*)(ws + OFF_WKVT), 2048, 256, m0, n0, lds);
    const int lane = fresh_tid() & 63, r32 = lane & 31, h = lane >> 5;
    store_strip_T<true>(acc, (u16*)(ws + OFF_MVT), hd * 128 + wc * 64, tok0, sskv, r32, h);
  } else {
    gemm_mainloop<false>(acc, (const u16*)(ws + OFF_CKV), S, (const u16*)(ws + OFF_WKVT), 2048, 256, m0, n0, lds);
    const int lane = fresh_tid() & 63, r32 = lane & 31, h = lane >> 5;
    float rs[4];
#pragma unroll
    for (int mt = 0; mt < 4; ++mt) rs[mt] = kv_rstd(sskv, tok0 + mt * 32 + r32);
    store_strip_rows<false>(acc, (u16*)(ws + OFF_KNOPE), 1024, hd * 128 + wc * 64, tok0, rs, r32, h, lds, wid, lane);
  }
}

DI void p4_tile(const Params& p, int tm, int tn, char* lds) {
  unsigned char* ws = p.ws;
  const int wid = __builtin_amdgcn_readfirstlane(fresh_tid() >> 6), wr = wid >> 1, wc = wid & 1;
  const int m0 = tm * GM, n0 = tn * GN, tok0 = m0 + wr * 128;
  f32x16 acc[4][2];
  gemm_mainloop<false>(acc, (const u16*)(ws + OFF_MIXED), S, (const u16*)(ws + OFF_WOT), 2048, 2048, m0, n0, lds);
  const int lane = fresh_tid() & 63, r32 = lane & 31, h = lane >> 5;
  const int fb = n0 + wc * 64;
  const float one[4] = {1.f, 1.f, 1.f, 1.f};
  store_strip_rows<false>(acc, (u16*)(ws + OFF_Y), 2048, fb, tok0, one, r32, h, lds, wid, lane);
  strip_sumsq(acc, (float*)(ws + OFF_YSS), 32, fb >> 6, tok0, one, r32, h);
}

constexpr int SB_VT = 24576, LDS_MISC = 40960;
constexpr int MLA_KN = 0, MLA_KR = 32768, MLA_VT = 49152;

DI void vt_load(u32x4 (&vreg)[4], const u16* VT, int head, int key0, int tid) {
  const char* base = (const char*)(VT + (size_t)(head * 128) * S + key0);
  const unsigned voff = (unsigned)(((tid >> 3) * S + (tid & 7) * 8) * 2);
#pragma unroll
  for (int i = 0; i < 4; ++i) vreg[i] = *(const u32x4*)(base + (size_t)(32 * i) * S * 2 + voff);
}
template <int LDS_VT>
DI void vt_write(const u32x4 (&vreg)[4], char* lds, int tid) {
  const int d = tid >> 3, c = tid & 7, sw = (d >> 1) & 7;
  char* b0 = lds + LDS_VT + d * 128 + ((c ^ sw) << 4);
#pragma unroll
  for (int i = 0; i < 4; ++i) *(u32x4*)(b0 + i * 4096) = vreg[i];
}
template <int LDS_VT>
DI void pv_tile(f32x16 (&o)[4], const bf16x8 (&pf)[2][2], const char* lds, int r32, int h) {
  const int sw = (r32 >> 1) & 7;
  const unsigned base = (unsigned)(size_t)(lds + LDS_VT + r32 * 128);
  unsigned adr[4];
#pragma unroll
  for (int k = 0; k < 4; ++k) adr[k] = base + (((2 * k + h) ^ sw) << 4);
  bf16x8 vf[4];
#define PV_READ(q) do { switch ((q) >> 2) { \
    case 0: ds_rd128<0>(vf[(q) & 3], adr[(q) & 3]); break; \
    case 1: ds_rd128<4096>(vf[(q) & 3], adr[(q) & 3]); break; \
    case 2: ds_rd128<8192>(vf[(q) & 3], adr[(q) & 3]); break; \
    default: ds_rd128<12288>(vf[(q) & 3], adr[(q) & 3]); break; } } while (0)
  PV_READ(0); PV_READ(1); PV_READ(2);
#pragma unroll
  for (int q = 0; q < 16; ++q) {
    if (q + 3 < 16) PV_READ(q + 3);
    if (q + 3 < 16) lgkm_wait1<3>(vf[q & 3]); else if (q + 2 < 16) lgkm_wait1<2>(vf[q & 3]); else if (q + 1 < 16) lgkm_wait1<1>(vf[q & 3]); else lgkm_wait1<0>(vf[q & 3]);
    o[q >> 2] = MFMA(vf[q & 3], pf[(q >> 1) & 1][q & 1], o[q >> 2]);
  }
#undef PV_READ
}
DI bf16x8 pack8(const f32x16& x, int s2) {
  const u32x4 w = {pack2(x[8 * s2], x[8 * s2 + 1]), pack2(x[8 * s2 + 2], x[8 * s2 + 3]), pack2(x[8 * s2 + 4], x[8 * s2 + 5]), pack2(x[8 * s2 + 6], x[8 * s2 + 7])};
  return __builtin_bit_cast(bf16x8, w);
}
DI void attn_store(const f32x16 (&o)[4], float scale, const u16* gate, u16* mixed, int tok, int col0, int h) {
  const u16* gp = gate + (size_t)tok * 2048 + col0 + 4 * h;
  u16* op = mixed + kblk(S, tok, col0) + 8 * h;
#pragma unroll
  for (int dt = 0; dt < 4; ++dt)
#pragma unroll
    for (int k = 0; k < 2; ++k) {
      u32x2 pk[2];
#pragma unroll
      for (int e = 0; e < 2; ++e) {
        const int g = 2 * k + e;
        const u32x2 gw = *(const u32x2*)(gp + dt * 32 + 8 * g);
        pk[e][0] = pack2(o[dt][4 * g] * scale * bflo(gw[0]), o[dt][4 * g + 1] * scale * bfhi(gw[0]));
        pk[e][1] = pack2(o[dt][4 * g + 2] * scale * bflo(gw[1]), o[dt][4 * g + 3] * scale * bfhi(gw[1]));
      }
      *(u32x4*)(op + (size_t)dt * S * 32 + 16 * k) = widen16(pk[0], pk[1]);
    }
}

DI void mla_item(const Params& p, int head, int qb, int t0, int t1, int mode, int pr, char* lds) {
  unsigned char* ws = p.ws;
  const int tid = fresh_tid(), wid = __builtin_amdgcn_readfirstlane(tid >> 6), lane = tid & 63, r32 = lane & 31, h = lane >> 5;
  const u16* Q = (const u16*)(ws + OFF_QMLA); const u16* KN = (const u16*)(ws + OFF_KNOPE); const u16* KR = (const u16*)(ws + OFF_KROT); const u16* VT = (const u16*)(ws + OFF_MVT);
  const int tok = qb * 128 + wid * 32 + r32;
  bf16x8 qf[12];
#pragma unroll
  for (int ks = 0; ks < 12; ++ks) qf[ks] = *(const bf16x8*)(Q + (size_t)tok * 1536 + head * 192 + ks * 16 + h * 8);
  f32x16 o[4];
#pragma unroll
  for (int dt = 0; dt < 4; ++dt)
#pragma unroll
    for (int r = 0; r < 16; ++r) o[dt][r] = 0.f;
  float m = -1e30f, l = 0.f;
  const int mynt = 2 * qb + 1 + (wid >> 1);
  constexpr float C = 0.07216878364870323f * 1.4426950408889634f;
  constexpr float MLA_THR = 8.f * 1.4426950408889634f;
  u32x4 vreg[4];
  const int knr = wid * 4 + (lane >> 4), krr = wid * 8 + (lane >> 3);
  const unsigned kn_off = (unsigned)((knr * 1024 + (((lane & 15) ^ (knr & 15)) * 8)) * 2);
  const unsigned kr_off = (unsigned)((krr * 64 + (((lane & 7) ^ ((krr >> 1) & 7)) * 8)) * 2);
  const unsigned v_off = (unsigned)(((tid >> 3) * S + (tid & 7) * 8) * 2);
#define STAGE_PIECE(i, tn) do { \
    if ((i) < 4) dma16((const char*)(KN + (size_t)(tn) * 64 * 1024 + head * 128) + kn_off + (i) * 32768, lds + MLA_KN + ((tn) & 1) * 16384 + wid * 1024 + (i) * 4096); \
    else if ((i) < 6) dma16((const char*)(KR + (size_t)(tn) * 64 * 64) + kr_off + ((i) - 4) * 4096, lds + MLA_KR + ((tn) & 1) * 8192 + wid * 1024 + ((i) - 4) * 4096); \
    else vreg[(i) - 6] = *(const u32x4*)((const char*)(VT + (size_t)(head * 128) * S + (size_t)(tn) * 64) + (size_t)(32 * ((i) - 6)) * S * 2 + v_off); } while (0)
  __syncthreads();
#pragma unroll
  for (int i = 0; i < 10; ++i) STAGE_PIECE(i, t0);
  const int sw16 = r32 & 15, sw8 = (r32 >> 1) & 7;
  const int swv = (r32 >> 1) & 7;
  const unsigned vbase = (unsigned)(size_t)(lds + MLA_VT + r32 * 128);
  unsigned adrv[4];
#pragma unroll
  for (int k = 0; k < 4; ++k) adrv[k] = vbase + (((2 * k + h) ^ swv) << 4);
  for (int t = t0; t < t1; ++t) {
    __syncthreads();
    vt_write<MLA_VT>(vreg, lds, tid);
    asm volatile("s_waitcnt vmcnt(0)" ::: "memory");
    __syncthreads();
    const bool more = t + 1 < t1;
    if (t < mynt) {
      const unsigned knu = (unsigned)(size_t)(lds + MLA_KN + (t & 1) * 16384 + r32 * 256);
      const unsigned kru = (unsigned)(size_t)(lds + MLA_KR + (t & 1) * 8192 + r32 * 128);
      f32x16 sa, sb;
#pragma unroll
      for (int r = 0; r < 16; ++r) { sa[r] = 0.f; sb[r] = 0.f; }
      bf16x8 kf[3];
      bf16x8 vf[4];
      bf16x8 pfa[2], pfb[2];
      float mx1 = 0.f, alpha = 1.f, negm = 0.f, ps = 0.f;
#define K_READ(j) do { const int ks_ = (j) % 12; \
        if (ks_ < 8) { const unsigned a_ = knu + (((2 * ks_ + h) ^ sw16) << 4); if ((j) >= 12) ds_rd128<8192>(kf[(j) % 3], a_); else ds_rd128<0>(kf[(j) % 3], a_); } \
        else { const unsigned a_ = kru + (((2 * (ks_ - 8) + h) ^ sw8) << 4); if ((j) >= 12) ds_rd128<4096>(kf[(j) % 3], a_); else ds_rd128<0>(kf[(j) % 3], a_); } } while (0)
#define V_READ(n) do { const int k_ = ((n) >> 3) * 2 + ((n) & 1); switch (((n) >> 1) & 3) { \
        case 0: ds_rd128<0>(vf[(n) & 3], adrv[k_]); break; \
        case 1: ds_rd128<4096>(vf[(n) & 3], adrv[k_]); break; \
        case 2: ds_rd128<8192>(vf[(n) & 3], adrv[k_]); break; \
        default: ds_rd128<12288>(vf[(n) & 3], adrv[k_]); break; } } while (0)
      K_READ(0); K_READ(1);
#pragma unroll
      for (int ks = 0; ks < 12; ++ks) {
        K_READ(ks + 2);
        lgkm_wait1<2>(kf[ks % 3]);
        sa = MFMA(kf[ks % 3], qf[ks], sa);
        if (more && ks < 10) STAGE_PIECE(ks, t + 1);
        __builtin_amdgcn_sched_barrier(0);
      }
#pragma unroll
      for (int ks = 0; ks < 12; ++ks) {
        if (ks < 10) K_READ(12 + ks + 2); else if (ks == 10) V_READ(0); else { V_READ(1); V_READ(2); }
        if (ks < 10) lgkm_wait1<2>(kf[ks % 3]); else if (ks == 10) lgkm_wait1<2>(kf[ks % 3]); else lgkm_wait1<3>(kf[ks % 3]);
        sb = MFMA(kf[ks % 3], qf[ks], sb);
        if (ks == 0) { mx1 = fmaxf(fmaxf(fmaxf(sa[0], sa[1]), fmaxf(sa[2], sa[3])), fmaxf(fmaxf(sa[4], sa[5]), fmaxf(sa[6], sa[7]))); }
        else if (ks == 1) { mx1 = fmaxf(mx1, fmaxf(fmaxf(fmaxf(sa[8], sa[9]), fmaxf(sa[10], sa[11])), fmaxf(fmaxf(sa[12], sa[13]), fmaxf(sa[14], sa[15])))); }
        else if (ks == 2) { const float mx = xhalf_max(mx1) * C;     if (__all(mx - m <= MLA_THR)) { alpha = 1.f; } else { const float mnew = fmaxf(m, mx); alpha = __builtin_amdgcn_exp2f(m - mnew); m = mnew; } negm = -m; }
        else if (ks == 3) { if (!__all(alpha == 1.f)) {
#pragma unroll
            for (int dt = 0; dt < 4; ++dt)
#pragma unroll
              for (int r = 0; r < 16; ++r) o[dt][r] *= alpha; } }
        else if (ks < 8) {
#pragma unroll
          for (int i = 0; i < 4; ++i) sa[4 * (ks - 4) + i] = __builtin_amdgcn_exp2f(fmaf(sa[4 * (ks - 4) + i], C, negm)); }
        else if (ks == 8) { ps = ((sa[0] + sa[1]) + (sa[2] + sa[3])) + ((sa[4] + sa[5]) + (sa[6] + sa[7])) + (((sa[8] + sa[9]) + (sa[10] + sa[11])) + ((sa[12] + sa[13]) + (sa[14] + sa[15]))); }
        else if (ks == 9) { l = l * alpha + ps; }
        else if (ks == 10) pfa[0] = pack8(sa, 0);
        else pfa[1] = pack8(sa, 1);
        __builtin_amdgcn_sched_barrier(0);
      }
#pragma unroll
      for (int q = 0; q < 8; ++q) {
        V_READ(q + 3);
        lgkm_wait1<3>(vf[q & 3]);
        o[q >> 1] = MFMA(vf[q & 3], pfa[q & 1], o[q >> 1]);
        if (q == 0) { mx1 = fmaxf(fmaxf(fmaxf(sb[0], sb[1]), fmaxf(sb[2], sb[3])), fmaxf(fmaxf(sb[4], sb[5]), fmaxf(sb[6], sb[7]))); }
        else if (q == 1) { mx1 = fmaxf(mx1, fmaxf(fmaxf(fmaxf(sb[8], sb[9]), fmaxf(sb[10], sb[11])), fmaxf(fmaxf(sb[12], sb[13]), fmaxf(sb[14], sb[15]))));
                           const float mx = xhalf_max(mx1) * C;     if (__all(mx - m <= MLA_THR)) { alpha = 1.f; } else { const float mnew = fmaxf(m, mx); alpha = __builtin_amdgcn_exp2f(m - mnew); m = mnew; } negm = -m; }
        else if (q < 6) {
#pragma unroll
          for (int i = 0; i < 4; ++i) sb[4 * (q - 2) + i] = __builtin_amdgcn_exp2f(fmaf(sb[4 * (q - 2) + i], C, negm)); }
        else if (q == 6) { ps = ((sb[0] + sb[1]) + (sb[2] + sb[3])) + ((sb[4] + sb[5]) + (sb[6] + sb[7])) + (((sb[8] + sb[9]) + (sb[10] + sb[11])) + ((sb[12] + sb[13]) + (sb[14] + sb[15]))); l = l * alpha + ps; }
        else { pfb[0] = pack8(sb, 0); pfb[1] = pack8(sb, 1); }
        __builtin_amdgcn_sched_barrier(0);
      }
      if (!__all(alpha == 1.f)) {
#pragma unroll
        for (int dt = 0; dt < 4; ++dt)
#pragma unroll
          for (int r = 0; r < 16; ++r) o[dt][r] *= alpha;
      }
      __builtin_amdgcn_sched_barrier(0);
#pragma unroll
      for (int q = 8; q < 16; ++q) {
        if (q + 3 < 16) V_READ(q + 3);
        if (q + 3 < 16) lgkm_wait1<3>(vf[q & 3]); else if (q + 2 < 16) lgkm_wait1<2>(vf[q & 3]); else if (q + 1 < 16) lgkm_wait1<1>(vf[q & 3]); else lgkm_wait1<0>(vf[q & 3]);
          o[(q >> 1) & 3] = MFMA(vf[q & 3], pfb[q & 1], o[(q >> 1) & 3]);
        __builtin_amdgcn_sched_barrier(0);
      }
#undef K_READ
#undef V_READ
    } else if (more) {
#pragma unroll
      for (int i = 0; i < 10; ++i) STAGE_PIECE(i, t + 1);
    }
  }
#undef STAGE_PIECE
  int tok2 = tok; asm volatile("" : "+v"(tok2));
  float* part = (float*)(ws + OFF_PART + (size_t)pr * PART_STRIDE);
  unsigned* flag = (unsigned*)(ws + OFF_FLAG) + pr;
  if (mode == 1) {
#pragma unroll
    for (int dt = 0; dt < 4; ++dt)
#pragma unroll
      for (int r = 0; r < 16; ++r) part[(dt * 16 + r) * 256 + tid] = o[dt][r];
    part[16384 + tid] = m; part[16384 + 256 + tid] = l;
    asm volatile("s_waitcnt vmcnt(0)" ::: "memory");
    __syncthreads();
    if (tid == 0) {
      __builtin_amdgcn_fence(__ATOMIC_RELEASE, "agent");
      asm volatile("s_waitcnt vmcnt(0)" ::: "memory");
      __hip_atomic_store(flag, 1u, __ATOMIC_RELAXED, __HIP_MEMORY_SCOPE_AGENT);
    }
    return;
  }
  if (mode == 2) {
    if (tid == 0) {
      unsigned sp = 0;
      while (__hip_atomic_load(flag, __ATOMIC_RELAXED, __HIP_MEMORY_SCOPE_AGENT) == 0u) { __builtin_amdgcn_s_sleep(2); if (++sp > (1u << 22)) break; }
      __builtin_amdgcn_fence(__ATOMIC_ACQUIRE, "agent");
      asm volatile("s_waitcnt vmcnt(0)" ::: "memory");
    }
    __syncthreads();
    const float mb = part[16384 + tid], lb = part[16384 + 256 + tid];
    const float mm = fmaxf(m, mb), fa = __builtin_amdgcn_exp2f(m - mm), fb = __builtin_amdgcn_exp2f(mb - mm);
    l = l * fa + lb * fb;
#pragma unroll
    for (int dt = 0; dt < 4; ++dt)
#pragma unroll
      for (int r = 0; r < 16; ++r) o[dt][r] = o[dt][r] * fa + part[(dt * 16 + r) * 256 + tid] * fb;
  }
  l = xhalf_sum(l);
  attn_store(o, 1.f / l, (const u16*)(ws + OFF_GATE), (u16*)(ws + OFF_MIXED), tok2, 1024 + head * 128, h);
}

constexpr float SB_DONE = -120.f;
DI void sb_block32(f32x16& s, float& c, int key0, int tok, int h) {
  constexpr float SC = 0.08838834764831845f;
  float lk[16];
#pragma unroll
  for (int r = 0; r < 16; ++r) {
    const int key = key0 + (r & 3) + 8 * (r >> 2) + 4 * h;
    const float z = s[r] * SC;
    const float sp = fmaxf(z, 0.f) + __logf(1.f + __expf(-fabsf(z)));
    const bool valid = key < tok;
    lk[r] = valid ? -sp : 0.f;
    s[r] = valid ? (z - sp) : -1e30f;
  }
  float G[4], PG[4], T[4];
#pragma unroll
  for (int g = 0; g < 4; ++g) { G[g] = (lk[4 * g] + lk[4 * g + 1]) + (lk[4 * g + 2] + lk[4 * g + 3]); PG[g] = xhalf_other(G[g], h); T[g] = G[g] + PG[g]; }
  float ST[4]; ST[3] = 0.f; ST[2] = T[3]; ST[1] = T[3] + T[2]; ST[0] = ST[1] + T[1];
  const float total = ST[0] + T[0];
#pragma unroll
  for (int g = 0; g < 4; ++g) {
    const float base = c + ST[g] + (h == 0 ? PG[g] : 0.f);
    const float l3 = base, l2 = l3 + lk[4 * g + 3], l1 = l2 + lk[4 * g + 2], l0 = l1 + lk[4 * g + 1];
    s[4 * g + 3] = __expf(s[4 * g + 3] + l3); s[4 * g + 2] = __expf(s[4 * g + 2] + l2);
    s[4 * g + 1] = __expf(s[4 * g + 1] + l1); s[4 * g]     = __expf(s[4 * g] + l0);
  }
  c += total;
}
DI void sb_item(const Params& p, int head, int qb, char* lds) {
  unsigned char* ws = p.ws;
  const int tid = fresh_tid(), wid = __builtin_amdgcn_readfirstlane(tid >> 6), lane = tid & 63, r32 = lane & 31, h = lane >> 5;
  const u16* Q = (const u16*)(ws + OFF_SBQ); const u16* Kg = (const u16*)(ws + OFF_SBK); const u16* VT = (const u16*)(ws + OFF_SBVT);
  const int tok = qb * 128 + wid * 32 + r32, tokmax = qb * 128 + wid * 32 + 31;
  unsigned qoff = (unsigned)((tok * 1024 + head * 128 + h * 8) * 2);
  f32x16 o[4];
#pragma unroll
  for (int dt = 0; dt < 4; ++dt)
#pragma unroll
    for (int r = 0; r < 16; ++r) o[dt][r] = 0.f;
  float c = 0.f; int wdone = 0;
  u32x4 kreg[4], vreg[4];
  const int srow = tid >> 3, sc = tid & 7;
  const unsigned k_off = (unsigned)((srow * 1024 + sc * 8) * 2);
  char* kw = lds + srow * 256 + ((sc ^ (srow & 15)) << 4);
#define K_LOAD(t) do { const char* a_ = (const char*)(Kg + (size_t)(t) * 64 * 1024 + head * 128); kreg[0] = *(const u32x4*)(a_ + k_off); kreg[1] = *(const u32x4*)(a_ + 128 + k_off); \
    kreg[2] = *(const u32x4*)(a_ + 32 * 2048 + k_off); kreg[3] = *(const u32x4*)(a_ + 32 * 2048 + 128 + k_off); } while (0)
#define K_WRITE() do { char* kw2_ = (char*)((size_t)kw ^ 128); *(u32x4*)(kw) = kreg[0]; *(u32x4*)(kw2_) = kreg[1]; \
    *(u32x4*)(kw + 32 * 256) = kreg[2]; *(u32x4*)(kw2_ + 32 * 256) = kreg[3]; } while (0)
  const int T0 = 2 * qb + 1;
  K_LOAD(T0); vt_load(vreg, VT, head, T0 * 64, tid);
  volatile int* flags = (volatile int*)(lds + LDS_MISC + 16);
  const char* kb0 = lds + r32 * 256;
  const int sw = r32 & 15;
  for (int t = T0; t >= 0; --t) {
    if (lane == 0) flags[wid] = wdone;
    __syncthreads();
    if (flags[0] & flags[1] & flags[2] & flags[3]) break;
    K_WRITE(); vt_write<SB_VT>(vreg, lds, tid);
    __syncthreads();
    bf16x8 pf[2][2];
    const bool act = (t * 64 < tokmax) && !wdone;
    if (act) {
      bf16x8 qf[8];
      asm volatile("" : "+v"(qoff));
#pragma unroll
      for (int ks = 0; ks < 8; ++ks) qf[ks] = *(const bf16x8*)((const char*)Q + qoff + ks * 32);
      {
        f32x16 s1;
#pragma unroll
        for (int r = 0; r < 16; ++r) s1[r] = 0.f;
#pragma unroll
        for (int ks = 0; ks < 8; ++ks) s1 = MFMA(*(const bf16x8*)(kb0 + 32 * 256 + (((2 * ks + h) ^ sw) << 4)), qf[ks], s1);
        sb_block32(s1, c, t * 64 + 32, tok, h);
        pf[1][0] = pack8(s1, 0); pf[1][1] = pack8(s1, 1);
      }
      __builtin_amdgcn_sched_barrier(0);
      {
        f32x16 s0;
#pragma unroll
        for (int r = 0; r < 16; ++r) s0[r] = 0.f;
#pragma unroll
        for (int ks = 0; ks < 8; ++ks) s0 = MFMA(*(const bf16x8*)(kb0 + (((2 * ks + h) ^ sw) << 4)), qf[ks], s0);
        sb_block32(s0, c, t * 64, tok, h);
        pf[0][0] = pack8(s0, 0); pf[0][1] = pack8(s0, 1);
      }
    }
    if (t > 0) { K_LOAD(t - 1); vt_load(vreg, VT, head, (t - 1) * 64, tid); }
    if (act) { pv_tile<SB_VT>(o, pf, lds, r32, h); wdone = __all(c < SB_DONE) ? 1 : 0; }
  }
#undef K_LOAD
#undef K_WRITE
  int tok2 = tok; asm volatile("" : "+v"(tok2));
  attn_store(o, 1.f, (const u16*)(ws + OFF_GATE), (u16*)(ws + OFF_MIXED), tok2, head * 128, h);
}

struct TDesc { const float* src; const float* scale; u16* dst; int K, N, k0, n0, rows; };
DI TDesc tile_desc(const Params& p, int t) {
  constexpr int T_IN = 32 * 94, T_OUT = 32 * 32, T_Q = 8 * 24;
  unsigned char* ws = p.ws; TDesc d;
  if (t < T_IN) { const int kt = t / 94, nt = t - kt * 94; d = {p.w_in, p.pre_w, (u16*)(ws + OFF_WINT), DM, DIN, kt * 64, nt * 64, DINP}; }
  else if (t < T_IN + T_OUT) { const int u = t - T_IN; d = {p.w_out, nullptr, (u16*)(ws + OFF_WOT), 2048, 2048, (u >> 5) * 64, (u & 31) * 64, 2048}; }
  else if (t < T_IN + T_OUT + T_Q) { const int u = t - T_IN - T_OUT, kt = u / 24, nt = u - kt * 24; d = {p.w_qup, p.qn_w, (u16*)(ws + OFF_WQT), 512, 1536, kt * 64, nt * 64, 1536}; }
  else { const int u = t - T_IN - T_OUT - T_Q; d = {p.w_kvup, p.kvn_w, (u16*)(ws + OFF_WKVT), 256, 2048, (u >> 5) * 64, (u & 31) * 64, 2048}; }
  return d;
}
DI void tr_load(f32x4 (&reg)[4], float (&sc)[4], const TDesc& d, int tid) {
#pragma unroll
  for (int i = 0; i < 4; ++i) {
    const int idx = tid + 256 * i, kk = idx >> 4, n4 = (idx & 15) * 4;
    if (d.n0 < d.N) { reg[i] = *(const f32x4*)(d.src + (size_t)(d.k0 + kk) * d.N + d.n0 + n4); sc[i] = d.scale ? d.scale[d.k0 + kk] : 1.f; }
    else { reg[i] = f32x4{0.f, 0.f, 0.f, 0.f}; sc[i] = 0.f; }
  }
}
DI void phase0(const Params& p, char* lds) {
  unsigned char* ws = p.ws;
  const int tid = fresh_tid(), wid = __builtin_amdgcn_readfirstlane(tid >> 6), lane = tid & 63, nb = gridDim.x, bid = blockIdx.x;
  if (bid == 0) { unsigned* ctr = (unsigned*)(ws + OFF_CTR); if (tid < 16) ctr[tid] = 0u; ((unsigned*)(ws + OFF_FLAG))[tid] = 0u; }
  {
    constexpr int NT = 32 * 94 + 32 * 32 + 8 * 24 + 4 * 32;
    float* tl = (float*)lds;
    f32x4 reg[4]; float sc[4];
    int t = bid; TDesc d = tile_desc(p, t < NT ? t : 0);
    if (t < NT) tr_load(reg, sc, d, tid);
    while (t < NT) {
      __syncthreads();
#pragma unroll
      for (int i = 0; i < 4; ++i) {
        const int idx = tid + 256 * i, kk = idx >> 4, n4 = (idx & 15) * 4;
#pragma unroll
        for (int j = 0; j < 4; ++j) tl[kk * 65 + n4 + j] = reg[i][j] * sc[i];
      }
      __syncthreads();
      const TDesc dc = d;
      const int tn = t + nb;
      if (tn < NT) { d = tile_desc(p, tn); tr_load(reg, sc, d, tid); }
#pragma unroll
      for (int i = 0; i < 2; ++i) {
        const int idx = tid + 256 * i, nn = idx >> 3, m = idx & 7;
        const float* c0 = tl + (8 * m) * 65 + nn;
        u32x4 w = {pack2(c0[0], c0[65]), pack2(c0[130], c0[195]), pack2(c0[260], c0[325]), pack2(c0[390], c0[455])};
        *(u32x4*)(dc.dst + kblk(dc.rows, dc.n0 + nn, dc.k0 + 8 * m)) = w;
      }
      t = tn;
    }
  }
  float* COS = (float*)(ws + OFF_COS); float* SIN = (float*)(ws + OFF_SIN);
  for (int idx = bid * 256 + tid; idx < S * 32; idx += nb * 256) {
    const int tok = idx >> 5, i = idx & 31;
    const float inv = exp2f(-(float)i * (13.287712379549449f / 32.f));
    const float ang = (float)p.pos[tok] * inv;
    const double a = (double)ang * 0.15915494309189535;
    const float rev = (float)(a - rint(a));
    COS[idx] = __builtin_amdgcn_cosf(rev); SIN[idx] = __builtin_amdgcn_sinf(rev);
  }
  u16* XB = (u16*)(ws + OFF_XB); float* rstdx = (float*)(ws + OFF_RSTDX);
  for (int row = (bid * 4 + wid) * 2; row < S; row += nb * 8) {
    const f32x4* xr = (const f32x4*)(p.x + (size_t)row * DM);
    f32x4 v[16]; float ss0 = 0.f, ss1 = 0.f;
#pragma unroll
    for (int i = 0; i < 16; ++i) v[i] = xr[lane + 64 * i];
#pragma unroll
    for (int i = 0; i < 8; ++i) { ss0 += v[i][0] * v[i][0] + v[i][1] * v[i][1] + v[i][2] * v[i][2] + v[i][3] * v[i][3]; ss1 += v[i + 8][0] * v[i + 8][0] + v[i + 8][1] * v[i + 8][1] + v[i + 8][2] * v[i + 8][2] + v[i + 8][3] * v[i + 8][3]; }
    ss0 = wave_sum(ss0, lane); ss1 = wave_sum(ss1, lane);
    if (lane == 0) { rstdx[row] = rsqrtf(ss0 * (1.f / 2048.f) + EPS); rstdx[row + 1] = rsqrtf(ss1 * (1.f / 2048.f) + EPS); }
#pragma unroll
    for (int i = 0; i < 16; ++i) store4bf(XB + kblk(S, row + (i >> 3), ((lane + 64 * i) * 4) & 2047), v[i][0], v[i][1], v[i][2], v[i][3]);
  }
}

DI void phase5(const Params& p) {
  const int tid = fresh_tid(), wid = __builtin_amdgcn_readfirstlane(tid >> 6), lane = tid & 63, nb = gridDim.x, bid = blockIdx.x;
  const float* yss = (const float*)(p.ws + OFF_YSS); const u16* Y = (const u16*)(p.ws + OFF_Y);
  f32x4 w[8];
#pragma unroll
  for (int i = 0; i < 8; ++i) w[i] = ((const f32x4*)p.post_w)[lane + 64 * i];
  for (int row = (bid * 4 + wid) * 2; row < S; row += nb * 8) {
    const f32x4* xr = (const f32x4*)(p.x + (size_t)row * DM);
    const u32x2* yr = (const u32x2*)(Y + (size_t)row * DM);
    f32x4 xv[16]; u32x2 yv[16];
#pragma unroll
    for (int i = 0; i < 16; ++i) { xv[i] = xr[lane + 64 * i]; yv[i] = yr[lane + 64 * i]; }
    const float s0 = wave_sum(lane < 32 ? yss[(size_t)row * 32 + lane] : 0.f, lane), s1 = wave_sum(lane < 32 ? yss[(size_t)(row + 1) * 32 + lane] : 0.f, lane);
    const float rs0 = rsqrtf(s0 * (1.f / 2048.f) + EPS), rs1 = rsqrtf(s1 * (1.f / 2048.f) + EPS);
    f32x4* orow = (f32x4*)(p.out + (size_t)row * DM);
#pragma unroll
    for (int i = 0; i < 16; ++i) {
      const float rs = i < 8 ? rs0 : rs1; const f32x4 ww = w[i & 7];
      f32x4 r = {xv[i][0] + bflo(yv[i][0]) * rs * ww[0], xv[i][1] + bfhi(yv[i][0]) * rs * ww[1], xv[i][2] + bflo(yv[i][1]) * rs * ww[2], xv[i][3] + bfhi(yv[i][1]) * rs * ww[3]};
      orow[lane + 64 * i] = r;
    }
  }
}

#define XB_TMO      128
#define XB_XCNT(j)  (256  + 64 * (j))
#define XB_XSUB(j)  (1280 + 64 * (j))
#define XB_XGEN(j)  (2304 + 64 * (j))
#define XB_TOP      3328
#define XB_TOPGEN   3392
#define XCD_BAR_WORDS 3456
#define XB_SPIN_CAP (1u << 20)
#define LAS __attribute__((address_space(3)))
DI unsigned xb_ld(unsigned* p)              { return __hip_atomic_load(p, __ATOMIC_RELAXED, __HIP_MEMORY_SCOPE_AGENT); }
DI unsigned xb_add(unsigned* p, unsigned v) { return __hip_atomic_fetch_add(p, v, __ATOMIC_RELAXED, __HIP_MEMORY_SCOPE_AGENT); }
DI unsigned xb_xcc_id() { return (unsigned)__builtin_amdgcn_s_getreg((3 << 11) | 20) & 0xFu; }
#define XB_SPIN(cond, bar) do { unsigned _sp = 0; while (cond) { __builtin_amdgcn_s_sleep(1); \
    if ((++_sp & 255u) == 0u) { if (xb_ld(&(bar)[XB_TMO])) break; if (_sp > XB_SPIN_CAP) { atomicAdd(&(bar)[XB_TMO], 1u); break; } } } } while (0)
struct XcdBarrier { unsigned* bar; unsigned x; volatile LAS unsigned* st; };
DI XcdBarrier xcd_barrier_post(unsigned* bar, volatile LAS unsigned* st) {
  XcdBarrier b; b.bar = bar; b.x = xb_xcc_id(); b.st = st;
  if (threadIdx.x == 0) (void)xb_add(&bar[XB_XCNT(b.x)], 1u);
  return b;
}
DI void xcd_barrier_complete(unsigned* bar, unsigned x, unsigned& nloc, unsigned& nx) {
  const unsigned G = gridDim.x * gridDim.y * gridDim.z;
  unsigned sum, cnt, mine, sp = 0u;
  for (;;) {
    sum = 0u; cnt = 0u; mine = 0u;
#pragma unroll
    for (unsigned j = 0; j < 16; ++j) { const unsigned c = xb_ld(&bar[XB_XCNT(j)]); sum += c; cnt += (c > 0u) ? 1u : 0u; mine = (j == x) ? c : mine; }
    if (sum == G) break;
    __builtin_amdgcn_s_sleep(1);
    if ((++sp & 255u) == 0u) { if (xb_ld(&bar[XB_TMO])) break; if (sp > XB_SPIN_CAP) { atomicAdd(&bar[XB_TMO], 1u); break; } }
  }
  nloc = mine > 0u ? mine : 1u; nx = cnt > 0u ? cnt : 1u;
}
DI void xcd_barrier(const XcdBarrier& b) {
  asm volatile("s_waitcnt vmcnt(0)" ::: "memory");
  __syncthreads();
  if (threadIdx.x == 0) {
    unsigned* bar = b.bar;
    __builtin_amdgcn_s_waitcnt(0);
    unsigned nloc = b.st[0], nx = b.st[1];
    if (nloc == 0u) { xcd_barrier_complete(bar, b.x, nloc, nx); b.st[0] = nloc; b.st[1] = nx; }
    const unsigned old = xb_add(&bar[XB_XSUB(b.x)], 1u);
    const unsigned gen = old / nloc;
    if (old + 1u == (gen + 1u) * nloc) {
      __builtin_amdgcn_fence(__ATOMIC_RELEASE, "agent");
      asm volatile("s_waitcnt vmcnt(0)" ::: "memory");
      const unsigned og = xb_add(&bar[XB_TOP], 1u);
      const unsigned tg = og / nx;
      if (og + 1u == (tg + 1u) * nx) xb_add(&bar[XB_TOPGEN], 1u);
      else XB_SPIN(xb_ld(&bar[XB_TOPGEN]) == tg, bar);
      __builtin_amdgcn_fence(__ATOMIC_ACQUIRE, "agent");
      xb_add(&bar[XB_XGEN(b.x)], 1u);
      asm volatile("s_waitcnt vmcnt(0)" ::: "memory");
    } else {
      XB_SPIN(xb_ld(&bar[XB_XGEN(b.x)]) == gen, bar);
      __builtin_amdgcn_fence(__ATOMIC_ACQUIRE, "agent");
      asm volatile("s_waitcnt vmcnt(0)" ::: "memory");
    }
  }
  __syncthreads();
}

__global__ void __launch_bounds__(256, 2) fwd_megakernel(Params p) {
  extern __shared__ __attribute__((aligned(16))) char lds[];
  cg::grid_group grid = cg::this_grid();
  const int nb = gridDim.x, bid = blockIdx.x;
  if (p.ws == nullptr) grid.sync();
  volatile LAS unsigned* bst = (volatile LAS unsigned*)(lds + LDS_BARST);
  if (threadIdx.x == 0) { bst[0] = 0u; bst[1] = 0u; }
  __syncthreads();
  const XcdBarrier xb = xcd_barrier_post((unsigned*)(p.ws + OFF_BAR), bst);

  phase0(p, lds);
  xcd_barrier(xb);

  for (int t = bid; t < 32 * 47; t += nb) p1_tile(p, t & 31, t >> 5, lds);
  xcd_barrier(xb);

  for (int t = bid; t < 32 * 12 + 32 * 16; t += nb) {
    if (t < 32 * 12) p2_q_tile(p, t & 31, t >> 5, lds);
    else { const int u = t - 32 * 12; p2_kv_tile(p, u & 31, u >> 5, lds); }
  }
  xcd_barrier(xb);

  for (int it = 511 - bid; it >= 0; it -= nb) {
    const int half = it >> 8, j = (it & 255) >> 3, head = it & 7, pr = it & 255;
    if (half == 0) mla_item(p, head, 63 - j, 0, 65, 2, pr, lds);
    else {
#pragma unroll 1
      for (int seg = 0; seg < 2; ++seg) mla_item(p, head, seg ? j : 63 - j, seg ? 0 : 65, seg ? 2 * j + 2 : 128 - 2 * j, seg ? 0 : 1, pr, lds);
    }
  }
  {
    unsigned* ctr = (unsigned*)(p.ws + OFF_CTR);
    volatile int* itemw = (volatile int*)(lds + LDS_MISC);
    for (;;) {
      __syncthreads();
      if (threadIdx.x == 0) *itemw = (int)atomicAdd(ctr, 1u);
      __syncthreads();
      const int it = *itemw;
      if (it >= 512) break;
      sb_item(p, it & 7, 63 - (it >> 3), lds);
    }
  }
  xcd_barrier(xb);

  for (int t = bid; t < 32 * 16; t += nb) p4_tile(p, t & 31, t >> 5, lds);
  xcd_barrier(xb);

  phase5(p);
}

extern "C" void kernel_launch(void* const* d_in, const int* in_sizes, int n_in, void* d_out, int out_size, void* d_ws, size_t ws_size, hipStream_t stream) {
  static int grid_blocks = 0;
  if (grid_blocks == 0) {
    if (n_in != 10 || in_sizes[0] != S * DM || out_size != S * DM || ws_size < WS_END) {
      fprintf(stderr, "kernel_launch: unexpected shapes n_in %d in0 %d out %d ws %zu (need %zu)\n", n_in, n_in > 0 ? in_sizes[0] : -1, out_size, ws_size, (size_t)WS_END);
      grid_blocks = -1; return;
    }
    int dev = 0, cus = 0, per_cu = 0;
    hipGetDevice(&dev);
    hipDeviceGetAttribute(&cus, hipDeviceAttributeMultiprocessorCount, dev);
    hipFuncSetAttribute((const void*)fwd_megakernel, hipFuncAttributeMaxDynamicSharedMemorySize, LDS_BYTES);
    hipOccupancyMaxActiveBlocksPerMultiprocessor(&per_cu, (const void*)fwd_megakernel, 256, LDS_BYTES);
    if (per_cu < 1) per_cu = 1;
    if (per_cu > 2) per_cu = 2;
    grid_blocks = cus * per_cu;
  }
  if (grid_blocks < 0) return;
  Params p{};
  p.x = (const float*)d_in[0]; p.pos = (const int*)d_in[1]; p.pre_w = (const float*)d_in[2]; p.w_in = (const float*)d_in[3];
  p.qn_w = (const float*)d_in[4]; p.w_qup = (const float*)d_in[5]; p.kvn_w = (const float*)d_in[6]; p.w_kvup = (const float*)d_in[7];
  p.w_out = (const float*)d_in[8]; p.post_w = (const float*)d_in[9]; p.out = (float*)d_out; p.ws = (unsigned char*)d_ws;
  if (hipMemsetAsync((char*)d_ws + OFF_BAR, 0, XCD_BAR_WORDS * 4, stream) != hipSuccess) { fprintf(stderr, "kernel_launch: memset of barrier words failed\n"); return; }
  void* args[] = {&p};
  hipError_t e = hipLaunchCooperativeKernel((const void*)fwd_megakernel, dim3(grid_blocks), dim3(256), args, LDS_BYTES, stream);
  if (e != hipSuccess) fprintf(stderr, "cooperative launch failed: %s (grid %d)\n", hipGetErrorString(e), grid_blocks);
}
```
